# Optimizing an MI355X kernel written in HIP

```python
import math
import jax, jax.numpy as jnp
from jax import lax
import numpy as np

D_MODEL = 2048
BATCH = 4
SEQ = 2048
DEPTH = 2
DEC_BATCH = 128
DEC_SEQ = 1
PAST_LEN = 16384
PAGE_SIZE = 128

HEAD_DIM = 64
D_INNER = 2 * D_MODEL
N_HEADS = D_INNER // HEAD_DIM
N_GROUPS = 8
D_STATE = 128
CONV_K = 4
CONV_DIM = D_INNER + 2 * N_GROUPS * D_STATE
CHUNK = 128
D_POOL = D_MODEL
POOL_WINDOWS = (2, 4, 8, 16)
POOL_GROUPS = len(POOL_WINDOWS)
POOL_GC = D_POOL // POOL_GROUPS
POOL_BUF = max(POOL_WINDOWS) - 1
D_FF = 5504
FFN_K = 3
D_IN_TOTAL = D_INNER + CONV_DIM + N_HEADS + D_POOL + 2 * D_MODEL
IN_SPLITS = (D_INNER, D_INNER + CONV_DIM, D_INNER + CONV_DIM + N_HEADS,
             D_INNER + CONV_DIM + N_HEADS + D_POOL)
ALPHA = (2 * DEPTH) ** 0.25
BETA = (8 * DEPTH) ** -0.25
LN_EPS = 1e-5
RMS_EPS = 1e-5

kernel_name = "ssd_pool_gated_hybrid_deepnorm_step"


def layer_norm(x, g, b):
    xf = x.astype(jnp.float32)
    mu = jnp.mean(xf, axis=-1, keepdims=True)
    var = jnp.mean(jnp.square(xf - mu), axis=-1, keepdims=True)
    y = (xf - mu) * lax.rsqrt(var + LN_EPS) * g.astype(jnp.float32) + b.astype(jnp.float32)
    return y.astype(x.dtype)


def gated_rmsnorm(y, z, w):
    v = y.astype(jnp.float32) * jax.nn.silu(z.astype(jnp.float32))
    shp = v.shape
    v = v.reshape(shp[:-1] + (N_GROUPS, shp[-1] // N_GROUPS))
    v = v * lax.rsqrt(jnp.mean(jnp.square(v), axis=-1, keepdims=True) + RMS_EPS)
    return v.reshape(shp) * w.astype(jnp.float32)


def causal_dwconv(u, buf, w, b):
    k = w.shape[0]
    l = u.shape[1]
    ext = jnp.concatenate([buf.astype(u.dtype), u], axis=1)
    y = b
    for j in range(k):
        y = y + ext[:, j:j + l] * w[j]
    return y, ext[:, -(k - 1):]


def ssd_scan(xs, dt, a, bm, cm, s0):
    bsz, l, h, p = xs.shape
    g, n = bm.shape[2], bm.shape[3]
    r = h // g
    q = min(CHUNK, l)
    nc = -(-l // q)
    pad = nc * q - l
    if pad:
        pw4 = ((0, 0), (0, pad), (0, 0), (0, 0))
        xs = jnp.pad(xs, pw4)
        bm = jnp.pad(bm, pw4)
        cm = jnp.pad(cm, pw4)
        dt = jnp.pad(dt, ((0, 0), (0, pad), (0, 0)))
    xs = xs.astype(jnp.float32).reshape(bsz, nc, q, g, r, p)
    dt = dt.reshape(bsz, nc, q, g, r)
    bm = bm.astype(jnp.float32).reshape(bsz, nc, q, g, n)
    cm = cm.astype(jnp.float32).reshape(bsz, nc, q, g, n)
    a_cum = jnp.cumsum(dt * a.reshape(g, r), axis=2)
    xdt = xs * dt[..., None]
    causal = jnp.tril(jnp.ones((q, q), dtype=bool))[:, :, None, None]
    seg = a_cum[:, :, :, None] - a_cum[:, :, None]
    decay = jnp.where(causal, jnp.exp(jnp.where(causal, seg, 0.0)), 0.0)
    cb = jnp.einsum('bcign,bcjgn->bcijg', cm, bm)
    y_diag = jnp.einsum('bcijgr,bcjgrp->bcigrp', cb[..., None] * decay, xdt)
    end_decay = jnp.exp(a_cum[:, :, -1:] - a_cum)
    chunk_states = jnp.einsum('bcjgn,bcjgrp->bcgrpn', bm, xdt * end_decay[..., None])
    chunk_decay = jnp.exp(a_cum[:, :, -1])

    def step(s, inp):
        st, dc = inp
        return s * dc[..., None, None] + st, s

    s_init = s0.astype(jnp.float32).reshape(bsz, g, r, p, n)
    s_final, s_prev = lax.scan(step, s_init,
                               (jnp.moveaxis(chunk_states, 1, 0), jnp.moveaxis(chunk_decay, 1, 0)))
    s_prev = jnp.moveaxis(s_prev, 0, 1)
    y_off = jnp.einsum('bcign,bcgrpn->bcigrp', cm, s_prev) * jnp.exp(a_cum)[..., None]
    y = (y_diag + y_off).reshape(bsz, nc * q, h, p)[:, :l]
    return y, s_final.reshape(bsz, h, p, n)


def pool_mix(u, buf, start_pos, w_pool, scale):
    bsz, l, c = u.shape
    pb = buf.shape[1]
    ext = jnp.concatenate([buf.astype(u.dtype), u], axis=1)
    cs = jnp.concatenate([jnp.zeros((bsz, 1, c), jnp.float32),
                          jnp.cumsum(ext.astype(jnp.float32), axis=1)], axis=1)
    end = cs[:, pb + 1:]
    pos = start_pos + jnp.arange(l)
    means = []
    for gi, win in enumerate(POOL_WINDOWS):
        sl = slice(gi * POOL_GC, (gi + 1) * POOL_GC)
        win_sum = end[..., sl] - cs[:, pb + 1 - win: pb + 1 - win + l, sl]
        cnt = jnp.minimum(win, pos + 1).astype(jnp.float32)
        means.append(win_sum / cnt[None, :, None])
    pooled = jnp.concatenate(means, axis=-1) - u.astype(jnp.float32)
    pooled = pooled.reshape(bsz, l, POOL_GROUPS, POOL_GC)
    out = jnp.einsum('blgc,gcd->blgd', pooled, w_pool.astype(jnp.float32)).reshape(bsz, l, c)
    out = out * scale.astype(jnp.float32)
    return out.astype(u.dtype), ext[:, -pb:]


def layer(x, s_ssm, s_conv, s_pool, s_ffn, start_pos, lw):
    (w_in, b_gate, conv_w, conv_b, dt_bias, a_log, d_skip, norm_w, w_br, w_pool, pool_scale,
     w_out, ln1_g, ln1_b, w_up, fconv_w, fconv_b, w_down, ln2_g, ln2_b) = lw
    bsz, l, _ = x.shape
    proj = x @ w_in
    z, xbc, dt_raw, pool_in, gate_raw = jnp.split(proj, IN_SPLITS, axis=-1)
    xbc, new_conv = causal_dwconv(xbc, s_conv, conv_w, conv_b)
    xbc = jax.nn.silu(xbc)
    xs, bm, cm = jnp.split(xbc, (D_INNER, D_INNER + N_GROUPS * D_STATE), axis=-1)
    xs = xs.reshape(bsz, l, N_HEADS, HEAD_DIM)
    bm = bm.reshape(bsz, l, N_GROUPS, D_STATE)
    cm = cm.reshape(bsz, l, N_GROUPS, D_STATE)
    dt = jax.nn.softplus(dt_raw.astype(jnp.float32) + dt_bias.astype(jnp.float32))
    a = -jnp.exp(a_log.astype(jnp.float32))
    y, new_ssm = ssd_scan(xs, dt, a, bm, cm, s_ssm)
    y = y + d_skip.astype(jnp.float32)[:, None] * xs.astype(jnp.float32)
    y = gated_rmsnorm(y.reshape(bsz, l, D_INNER), z, norm_w).astype(x.dtype)
    y_a = y @ w_br
    y_b, new_pool = pool_mix(pool_in, s_pool, start_pos, w_pool, pool_scale)
    g_a, g_b = jnp.split(jax.nn.sigmoid(gate_raw + b_gate), 2, axis=-1)
    mix = (g_a * y_a + g_b * y_b) @ w_out
    x1 = layer_norm(ALPHA * x + mix, ln1_g, ln1_b)
    h, new_ffn = causal_dwconv(x1 @ w_up, s_ffn, fconv_w, fconv_b)
    hg, hv = jnp.split(h, 2, axis=-1)
    x2 = layer_norm(ALPHA * x1 + (jax.nn.silu(hg) * hv) @ w_down, ln2_g, ln2_b)
    return x2, new_ssm.astype(x.dtype), new_conv, new_pool, new_ffn


def setup_inputs(seed: int = 0) -> dict:
    key = jax.random.key(seed)
    ks = jax.random.split(key, 32)
    f32 = jnp.float32
    nrm = lambda k, shp, s: jax.random.normal(k, shp, f32) * s
    dt0 = jnp.exp(jax.random.uniform(ks[10], (DEPTH, N_HEADS), f32)
                  * (math.log(0.1) - math.log(0.001)) + math.log(0.001))
    return {
        "x_prompt": nrm(ks[0], (BATCH, SEQ, D_MODEL), 1.0),
        "x_sample": nrm(ks[1], (DEC_BATCH, DEC_SEQ, D_MODEL), 1.0),
        "state_ssm": nrm(ks[2], (DEPTH, DEC_BATCH, N_HEADS, HEAD_DIM, D_STATE), 0.1),
        "state_ssd_conv": nrm(ks[3], (DEPTH, DEC_BATCH, CONV_K - 1, CONV_DIM), 1.0),
        "state_pool": nrm(ks[4], (DEPTH, DEC_BATCH, POOL_BUF, D_POOL), 1.0),
        "state_ffn_conv": nrm(ks[5], (DEPTH, DEC_BATCH, FFN_K - 1, 2 * D_FF), 1.0),
        "w_in": nrm(ks[6], (DEPTH, D_MODEL, D_IN_TOTAL), D_MODEL ** -0.5),
        "b_gate": nrm(ks[7], (DEPTH, 2 * D_MODEL), 0.02),
        "conv_w": nrm(ks[8], (DEPTH, CONV_K, CONV_DIM), CONV_K ** -0.5),
        "conv_b": nrm(ks[9], (DEPTH, CONV_DIM), 0.02),
        "dt_bias": jnp.log(jnp.expm1(dt0)),
        "a_log": jnp.log(jax.random.uniform(ks[11], (DEPTH, N_HEADS), f32, 1.0, 16.0)),
        "d_skip": 1.0 + nrm(ks[12], (DEPTH, N_HEADS), 0.02),
        "ssd_norm_w": 1.0 + nrm(ks[13], (DEPTH, D_INNER), 0.02),
        "w_ssd_branch": nrm(ks[14], (DEPTH, D_INNER, D_MODEL), D_INNER ** -0.5),
        "w_pool": nrm(ks[15], (DEPTH, POOL_GROUPS, POOL_GC, POOL_GC), POOL_GC ** -0.5),
        "pool_scale": 1.0 + nrm(ks[16], (DEPTH, D_POOL), 0.1),
        "w_out": nrm(ks[17], (DEPTH, D_MODEL, D_MODEL), BETA * D_MODEL ** -0.5),
        "ln1_g": 1.0 + nrm(ks[18], (DEPTH, D_MODEL), 0.02),
        "ln1_b": nrm(ks[19], (DEPTH, D_MODEL), 0.02),
        "w_up": nrm(ks[20], (DEPTH, D_MODEL, 2 * D_FF), D_MODEL ** -0.5),
        "ffn_conv_w": nrm(ks[21], (DEPTH, FFN_K, 2 * D_FF), FFN_K ** -0.5),
        "ffn_conv_b": nrm(ks[22], (DEPTH, 2 * D_FF), 0.02),
        "w_down": nrm(ks[23], (DEPTH, D_FF, D_MODEL), BETA * D_FF ** -0.5),
        "ln2_g": 1.0 + nrm(ks[24], (DEPTH, D_MODEL), 0.02),
        "ln2_b": nrm(ks[25], (DEPTH, D_MODEL), 0.02),
    }


def reference(x_prompt, x_sample, state_ssm, state_ssd_conv, state_pool, state_ffn_conv,
              w_in, b_gate, conv_w, conv_b, dt_bias, a_log, d_skip, ssd_norm_w, w_ssd_branch,
              w_pool, pool_scale, w_out, ln1_g, ln1_b, w_up, ffn_conv_w, ffn_conv_b, w_down,
              ln2_g, ln2_b):
    yp, ys = x_prompt, x_sample
    bp = x_prompt.shape[0]
    dtp = x_prompt.dtype
    p_ssm, p_conv, p_pool, p_ffn = [], [], [], []
    s_ssm, s_conv, s_pool, s_ffn = [], [], [], []
    for i in range(DEPTH):
        lw = (w_in[i], b_gate[i], conv_w[i], conv_b[i], dt_bias[i], a_log[i], d_skip[i],
              ssd_norm_w[i], w_ssd_branch[i], w_pool[i], pool_scale[i], w_out[i],
              ln1_g[i], ln1_b[i], w_up[i], ffn_conv_w[i], ffn_conv_b[i], w_down[i],
              ln2_g[i], ln2_b[i])
        yp, a1, a2, a3, a4 = layer(
            yp,
            jnp.zeros((bp, N_HEADS, HEAD_DIM, D_STATE), dtp),
            jnp.zeros((bp, CONV_K - 1, CONV_DIM), dtp),
            jnp.zeros((bp, POOL_BUF, D_POOL), dtp),
            jnp.zeros((bp, FFN_K - 1, 2 * D_FF), dtp),
            0, lw)
        ys, b1, b2, b3, b4 = layer(ys, state_ssm[i], state_ssd_conv[i], state_pool[i],
                                   state_ffn_conv[i], PAST_LEN, lw)
        p_ssm.append(a1); p_conv.append(a2); p_pool.append(a3); p_ffn.append(a4)
        s_ssm.append(b1); s_conv.append(b2); s_pool.append(b3); s_ffn.append(b4)
    return (yp, ys,
            jnp.stack(p_ssm), jnp.stack(p_conv), jnp.stack(p_pool), jnp.stack(p_ffn),
            jnp.stack(s_ssm), jnp.stack(s_conv), jnp.stack(s_pool), jnp.stack(s_ffn))
```

```cpp
#include <hip/hip_runtime.h>
#include <cstdio>
#include <cstdint>

namespace base {
constexpr int DM = 2048, NB = 4, SEQ = 2048, DEPTH = 2, NDEC = 128;
constexpr int MP = NB * SEQ;
constexpr int MT = MP + NDEC;
constexpr int DI = 4096, NH = 64, HD = 64, NG = 8, DS = 128, CD = 6144;
constexpr int DP = 2048, PB = 15, DFF = 5504, DIN = 16448;
constexpr int OFF_Z = 0, OFF_XBC = 4096, OFF_DT = 10240, OFF_POOL = 10304, OFF_GATE = 12352;
constexpr float ALPHA = 1.4142135623730951f;
constexpr float LN_EPS = 1e-5f, RMS_EPS = 1e-5f;

constexpr size_t O_YP = 0;
constexpr size_t O_YS = O_YP + (size_t)NB * SEQ * DM;
constexpr size_t O_SSM_P = O_YS + (size_t)NDEC * DM;
constexpr size_t O_CONV_P = O_SSM_P + (size_t)DEPTH * NB * NH * HD * DS;
constexpr size_t O_POOL_P = O_CONV_P + (size_t)DEPTH * NB * 3 * CD;
constexpr size_t O_FFN_P = O_POOL_P + (size_t)DEPTH * NB * PB * DP;
constexpr size_t O_SSM_S = O_FFN_P + (size_t)DEPTH * NB * 2 * 2 * DFF;
constexpr size_t O_CONV_S = O_SSM_S + (size_t)DEPTH * NDEC * NH * HD * DS;
constexpr size_t O_POOL_S = O_CONV_S + (size_t)DEPTH * NDEC * 3 * CD;
constexpr size_t O_FFN_S = O_POOL_S + (size_t)DEPTH * NDEC * PB * DP;
constexpr size_t O_END = O_FFN_S + (size_t)DEPTH * NDEC * 2 * 2 * DFF;

__device__ __forceinline__ float siluf(float x) { return x / (1.f + __expf(-x)); }
__device__ __forceinline__ float sigmf(float x) { return 1.f / (1.f + __expf(-x)); }
__device__ __forceinline__ float softplusf(float x) { return x > 20.f ? x : log1pf(expf(x)); }

__global__ __launch_bounds__(256) void sgemm(const float* __restrict__ A, int lda, const float* __restrict__ B, int ldb,
                                             float* __restrict__ C, int ldc, int M, int N, int K) {
    __shared__ float As[16][128 + 4];
    __shared__ float Bs[16][128 + 4];
    const int tid = threadIdx.x, tx = tid & 15, ty = tid >> 4;
    const int m0 = blockIdx.y * 128, n0 = blockIdx.x * 128;
    float acc[8][8];
#pragma unroll
    for (int i = 0; i < 8; ++i)
#pragma unroll
        for (int j = 0; j < 8; ++j) acc[i][j] = 0.f;
    for (int k0 = 0; k0 < K; k0 += 16) {
#pragma unroll
        for (int j = 0; j < 2; ++j) {
            const int r = (tid >> 2) + 64 * j, c4 = tid & 3;
            float4 v = make_float4(0.f, 0.f, 0.f, 0.f);
            if (m0 + r < M) v = *(const float4*)(A + (size_t)(m0 + r) * lda + k0 + c4 * 4);
            As[c4 * 4 + 0][r] = v.x; As[c4 * 4 + 1][r] = v.y; As[c4 * 4 + 2][r] = v.z; As[c4 * 4 + 3][r] = v.w;
        }
#pragma unroll
        for (int j = 0; j < 2; ++j) {
            const int kk = (tid >> 5) + 8 * j, c4 = tid & 31;
            float4 v = make_float4(0.f, 0.f, 0.f, 0.f);
            if (n0 + c4 * 4 < N) v = *(const float4*)(B + (size_t)(k0 + kk) * ldb + n0 + c4 * 4);
            *(float4*)&Bs[kk][c4 * 4] = v;
        }
        __syncthreads();
#pragma unroll
        for (int kk = 0; kk < 16; ++kk) {
            float a[8], b[8];
            *(float4*)&a[0] = *(const float4*)&As[kk][ty * 8]; *(float4*)&a[4] = *(const float4*)&As[kk][ty * 8 + 4];
            *(float4*)&b[0] = *(const float4*)&Bs[kk][tx * 8]; *(float4*)&b[4] = *(const float4*)&Bs[kk][tx * 8 + 4];
#pragma unroll
            for (int i = 0; i < 8; ++i)
#pragma unroll
                for (int j = 0; j < 8; ++j) acc[i][j] = fmaf(a[i], b[j], acc[i][j]);
        }
        __syncthreads();
    }
#pragma unroll
    for (int i = 0; i < 8; ++i) {
        const int r = m0 + ty * 8 + i;
        if (r >= M) continue;
#pragma unroll
        for (int j = 0; j < 8; j += 4) {
            const int c = n0 + tx * 8 + j;
            if (c < N) *(float4*)(C + (size_t)r * ldc + c) = make_float4(acc[i][j], acc[i][j + 1], acc[i][j + 2], acc[i][j + 3]);
        }
    }
}

__global__ __launch_bounds__(256) void k_conv_xbc(const float* __restrict__ PROJ, const float* __restrict__ st_conv  ,
                                                  const float* __restrict__ cw  , const float* __restrict__ cb, float* __restrict__ XBC,
                                                  float* __restrict__ out_p  , float* __restrict__ out_s  ) {
    const size_t idx = (size_t)blockIdx.x * 256 + threadIdx.x;
    if (idx >= (size_t)MT * CD) return;
    const int r = (int)(idx / CD), c = (int)(idx % CD);
    float v[4];
    if (r < MP) {
        const int t = r % SEQ;
#pragma unroll
        for (int j = 0; j < 4; ++j) { const int tt = t + j - 3; v[j] = tt >= 0 ? PROJ[(size_t)(r + j - 3) * DIN + OFF_XBC + c] : 0.f; }
        if (t >= SEQ - 3) out_p[((size_t)(r / SEQ) * 3 + (t - (SEQ - 3))) * CD + c] = v[3];
    } else {
        const int s = r - MP;
#pragma unroll
        for (int j = 0; j < 3; ++j) v[j] = st_conv[((size_t)s * 3 + j) * CD + c];
        v[3] = PROJ[(size_t)r * DIN + OFF_XBC + c];
        out_s[((size_t)s * 3 + 0) * CD + c] = v[1]; out_s[((size_t)s * 3 + 1) * CD + c] = v[2]; out_s[((size_t)s * 3 + 2) * CD + c] = v[3];
    }
    float y = cb[c];
#pragma unroll
    for (int j = 0; j < 4; ++j) y = fmaf(cw[(size_t)j * CD + c], v[j], y);
    XBC[idx] = siluf(y);
}

__global__ __launch_bounds__(256) void k_ssd(const float* __restrict__ PROJ, const float* __restrict__ XBC, const float* __restrict__ st_ssm  ,
                                             const float* __restrict__ dt_bias, const float* __restrict__ a_log, const float* __restrict__ d_skip,
                                             float* __restrict__ V, float* __restrict__ out_p  , float* __restrict__ out_s  ) {
    const int blk = blockIdx.x, tid = threadIdx.x, p = tid >> 2, q = tid & 3;
    int h, row0, L; const float* sin = nullptr; float* sout;
    if (blk < NB * NH) { const int b = blk / NH; h = blk % NH; row0 = b * SEQ; L = SEQ; sout = out_p + ((size_t)b * NH + h) * HD * DS; }
    else { const int i = blk - NB * NH, s = i / NH; h = i % NH; row0 = MP + s; L = 1; sin = st_ssm + ((size_t)s * NH + h) * HD * DS; sout = out_s + ((size_t)s * NH + h) * HD * DS; }
    float S[32];
#pragma unroll
    for (int i = 0; i < 32; ++i) S[i] = sin ? sin[(size_t)p * DS + q * 32 + i] : 0.f;
    const float a = -expf(a_log[h]), dtb = dt_bias[h], D = d_skip[h];
    const int g = h / 8;
    for (int t = 0; t < L; ++t) {
        const size_t r = (size_t)(row0 + t);
        const float dt = softplusf(PROJ[r * DIN + OFF_DT + h] + dtb);
        const float dA = expf(dt * a);
        const float x = XBC[r * CD + h * HD + p];
        const float* Bp = XBC + r * CD + DI + g * DS + q * 32;
        const float* Cp = XBC + r * CD + DI + NG * DS + g * DS + q * 32;
        const float dx = dt * x;
        float acc = 0.f;
#pragma unroll
        for (int i = 0; i < 32; ++i) { S[i] = fmaf(S[i], dA, dx * Bp[i]); acc = fmaf(Cp[i], S[i], acc); }
        acc += __shfl_xor(acc, 1); acc += __shfl_xor(acc, 2);
        const float y = acc + D * x;
        const float z = PROJ[r * DIN + OFF_Z + h * HD + p];
        if (q == 0) V[r * DI + h * HD + p] = y * siluf(z);
    }
#pragma unroll
    for (int i = 0; i < 32; ++i) sout[(size_t)p * DS + q * 32 + i] = S[i];
}

__global__ __launch_bounds__(128) void k_rmsnorm(const float* __restrict__ V, const float* __restrict__ w, float* __restrict__ YN) {
    __shared__ float red[2];
    const int r = blockIdx.x >> 3, g = blockIdx.x & 7, tid = threadIdx.x;
    const size_t base = (size_t)r * DI + g * 512 + tid * 4;
    const float4 v = *(const float4*)(V + base);
    float s = v.x * v.x + v.y * v.y + v.z * v.z + v.w * v.w;
#pragma unroll
    for (int o = 1; o < 64; o <<= 1) s += __shfl_xor(s, o);
    if ((tid & 63) == 0) red[tid >> 6] = s;
    __syncthreads();
    const float rstd = rsqrtf((red[0] + red[1]) * (1.f / 512.f) + RMS_EPS);
    const float4 ww = *(const float4*)(w + g * 512 + tid * 4);
    *(float4*)(YN + base) = make_float4(v.x * rstd * ww.x, v.y * rstd * ww.y, v.z * rstd * ww.z, v.w * rstd * ww.w);
}

__global__ __launch_bounds__(256) void k_pool(const float* __restrict__ PROJ, const float* __restrict__ st_pool  , float* __restrict__ POOLED,
                                              float* __restrict__ out_p  , float* __restrict__ out_s  ) {
    const size_t idx = (size_t)blockIdx.x * 256 + threadIdx.x;
    if (idx >= (size_t)MT * DP) return;
    const int r = (int)(idx / DP), c = (int)(idx % DP);
    const int win = 2 << (c / 512);
    const float u = PROJ[(size_t)r * DIN + OFF_POOL + c];
    float sum = u; int cnt;
    if (r < MP) {
        const int t = r % SEQ; cnt = (t + 1 < win) ? t + 1 : win;
        for (int k = 1; k < cnt; ++k) sum += PROJ[(size_t)(r - k) * DIN + OFF_POOL + c];
        if (t >= SEQ - PB) out_p[((size_t)(r / SEQ) * PB + (t - (SEQ - PB))) * DP + c] = u;
    } else {
        const int s = r - MP; cnt = win;
        for (int k = 1; k < win; ++k) sum += st_pool[((size_t)s * PB + (PB - k)) * DP + c];
        for (int j = 0; j < PB - 1; ++j) out_s[((size_t)s * PB + j) * DP + c] = st_pool[((size_t)s * PB + j + 1) * DP + c];
        out_s[((size_t)s * PB + PB - 1) * DP + c] = u;
    }
    POOLED[idx] = sum / (float)cnt - u;
}

__global__ __launch_bounds__(256) void k_mix(const float* __restrict__ PROJ, const float* __restrict__ bg, const float* __restrict__ YA, const float* __restrict__ YB,
                                             const float* __restrict__ pscale, float* __restrict__ MIX) {
    const size_t idx = (size_t)blockIdx.x * 256 + threadIdx.x;
    if (idx >= (size_t)MT * DM) return;
    const int r = (int)(idx / DM), c = (int)(idx % DM);
    const float ga = sigmf(PROJ[(size_t)r * DIN + OFF_GATE + c] + bg[c]);
    const float gb = sigmf(PROJ[(size_t)r * DIN + OFF_GATE + DM + c] + bg[DM + c]);
    MIX[idx] = ga * YA[idx] + gb * (YB[idx] * pscale[c]);
}

__global__ __launch_bounds__(256) void k_ln(const float* __restrict__ res, const float* __restrict__ add, const float* __restrict__ g, const float* __restrict__ b, float* __restrict__ out) {
    __shared__ float red[4];
    const int r = blockIdx.x, tid = threadIdx.x;
    const size_t base = (size_t)r * DM + tid * 8;
    float v[8];
#pragma unroll
    for (int j = 0; j < 8; ++j) v[j] = ALPHA * res[base + j] + add[base + j];
    float s = 0.f;
#pragma unroll
    for (int j = 0; j < 8; ++j) s += v[j];
#pragma unroll
    for (int o = 1; o < 64; o <<= 1) s += __shfl_xor(s, o);
    if ((tid & 63) == 0) red[tid >> 6] = s;
    __syncthreads();
    const float mu = (red[0] + red[1] + red[2] + red[3]) * (1.f / DM);
    __syncthreads();
    float q = 0.f;
#pragma unroll
    for (int j = 0; j < 8; ++j) { v[j] -= mu; q += v[j] * v[j]; }
#pragma unroll
    for (int o = 1; o < 64; o <<= 1) q += __shfl_xor(q, o);
    if ((tid & 63) == 0) red[tid >> 6] = q;
    __syncthreads();
    const float rstd = rsqrtf((red[0] + red[1] + red[2] + red[3]) * (1.f / DM) + LN_EPS);
#pragma unroll
    for (int j = 0; j < 8; ++j) out[base + j] = v[j] * rstd * g[tid * 8 + j] + b[tid * 8 + j];
}

__global__ __launch_bounds__(256) void k_ffn(const float* __restrict__ H, const float* __restrict__ st_ffn  , const float* __restrict__ fw  ,
                                             const float* __restrict__ fb, float* __restrict__ HACT, float* __restrict__ out_p  , float* __restrict__ out_s  ) {
    const size_t idx = (size_t)blockIdx.x * 256 + threadIdx.x;
    if (idx >= (size_t)MT * DFF) return;
    const int r = (int)(idx / DFF), c = (int)(idx % DFF);
    float hv[2];
#pragma unroll
    for (int half = 0; half < 2; ++half) {
        const int col = c + half * DFF;
        float v0, v1; const float v2 = H[(size_t)r * 2 * DFF + col];
        if (r < MP) {
            const int t = r % SEQ;
            v0 = t >= 2 ? H[(size_t)(r - 2) * 2 * DFF + col] : 0.f; v1 = t >= 1 ? H[(size_t)(r - 1) * 2 * DFF + col] : 0.f;
            if (t >= SEQ - 2) out_p[((size_t)(r / SEQ) * 2 + (t - (SEQ - 2))) * 2 * DFF + col] = v2;
        } else {
            const int s = r - MP;
            v0 = st_ffn[((size_t)s * 2 + 0) * 2 * DFF + col]; v1 = st_ffn[((size_t)s * 2 + 1) * 2 * DFF + col];
            out_s[((size_t)s * 2 + 0) * 2 * DFF + col] = v1; out_s[((size_t)s * 2 + 1) * 2 * DFF + col] = v2;
        }
        hv[half] = fb[col] + fw[col] * v0 + fw[(size_t)2 * DFF + col] * v1 + fw[(size_t)4 * DFF + col] * v2;
    }
    HACT[idx] = siluf(hv[0]) * hv[1];
}

static void gemm(hipStream_t st, const float* A, int lda, const float* B, int ldb, float* C, int ldc, int M, int N, int K) {
    dim3 grid((N + 127) / 128, (M + 127) / 128);
    hipLaunchKernelGGL(sgemm, grid, dim3(256), 0, st, A, lda, B, ldb, C, ldc, M, N, K);
}
}

extern "C" void kernel_launch(void* const* d_in, const int* in_sizes, int n_in, void* d_out, int out_size, void* d_ws, size_t ws_size, hipStream_t stream) {
    using namespace base;
    if (n_in != 26 || (size_t)out_size != O_END) { fprintf(stderr, "kernel_launch: unexpected n_in %d / out_size %d (want 26 / %zu)\n", n_in, out_size, (size_t)O_END); return; }
    const float* x_prompt = (const float*)d_in[0]; const float* x_sample = (const float*)d_in[1];
    const float* state_ssm = (const float*)d_in[2]; const float* state_conv = (const float*)d_in[3];
    const float* state_pool = (const float*)d_in[4]; const float* state_ffn = (const float*)d_in[5];
    const float* w_in = (const float*)d_in[6]; const float* b_gate = (const float*)d_in[7];
    const float* conv_w = (const float*)d_in[8]; const float* conv_b = (const float*)d_in[9];
    const float* dt_bias = (const float*)d_in[10]; const float* a_log = (const float*)d_in[11]; const float* d_skip = (const float*)d_in[12];
    const float* norm_w = (const float*)d_in[13]; const float* w_br = (const float*)d_in[14]; const float* w_pool = (const float*)d_in[15];
    const float* pool_scale = (const float*)d_in[16]; const float* w_out = (const float*)d_in[17];
    const float* ln1_g = (const float*)d_in[18]; const float* ln1_b = (const float*)d_in[19];
    const float* w_up = (const float*)d_in[20]; const float* fconv_w = (const float*)d_in[21]; const float* fconv_b = (const float*)d_in[22];
    const float* w_down = (const float*)d_in[23]; const float* ln2_g = (const float*)d_in[24]; const float* ln2_b = (const float*)d_in[25];
    float* out = (float*)d_out;

    float* ws = (float*)d_ws; size_t o = 0;
    auto take = [&](size_t n) { float* p = ws + o; o += (n + 63) & ~(size_t)63; return p; };
    float* XA = take((size_t)MT * DM); float* XBb = take((size_t)MT * DM);
    float* PROJ = take((size_t)MT * DIN);
    float* XBC = take((size_t)MT * CD);
    float* V = take((size_t)MT * DI); float* YN = take((size_t)MT * DI);
    float* YA = take((size_t)MT * DM); float* POOLED = take((size_t)MT * DM); float* YB = take((size_t)MT * DM);
    float* MIX = take((size_t)MT * DM); float* MO = take((size_t)MT * DM); float* X1 = take((size_t)MT * DM); float* DN = take((size_t)MT * DM);
    float* H = PROJ; float* HACT = XBC;
    if (o * sizeof(float) > ws_size) { fprintf(stderr, "kernel_launch: workspace too small (%zu < %zu)\n", ws_size, o * sizeof(float)); return; }

    hipMemcpyAsync(XA, x_prompt, (size_t)MP * DM * sizeof(float), hipMemcpyDeviceToDevice, stream);
    hipMemcpyAsync(XA + (size_t)MP * DM, x_sample, (size_t)NDEC * DM * sizeof(float), hipMemcpyDeviceToDevice, stream);
    float* xin = XA; float* xnext = XBb;
    for (int l = 0; l < DEPTH; ++l) {
        gemm(stream, xin, DM, w_in + (size_t)l * DM * DIN, DIN, PROJ, DIN, MT, DIN, DM);
        hipLaunchKernelGGL(k_conv_xbc, dim3((unsigned)(((size_t)MT * CD + 255) / 256)), dim3(256), 0, stream, PROJ, state_conv + (size_t)l * NDEC * 3 * CD,
                           conv_w + (size_t)l * 4 * CD, conv_b + (size_t)l * CD, XBC, out + O_CONV_P + (size_t)l * NB * 3 * CD, out + O_CONV_S + (size_t)l * NDEC * 3 * CD);
        hipLaunchKernelGGL(k_ssd, dim3(NB * NH + NDEC * NH), dim3(256), 0, stream, PROJ, XBC, state_ssm + (size_t)l * NDEC * NH * HD * DS, dt_bias + l * NH, a_log + l * NH, d_skip + l * NH,
                           V, out + O_SSM_P + (size_t)l * NB * NH * HD * DS, out + O_SSM_S + (size_t)l * NDEC * NH * HD * DS);
        hipLaunchKernelGGL(k_rmsnorm, dim3(MT * 8), dim3(128), 0, stream, V, norm_w + (size_t)l * DI, YN);
        gemm(stream, YN, DI, w_br + (size_t)l * DI * DM, DM, YA, DM, MT, DM, DI);
        hipLaunchKernelGGL(k_pool, dim3((unsigned)(((size_t)MT * DP + 255) / 256)), dim3(256), 0, stream, PROJ, state_pool + (size_t)l * NDEC * PB * DP, POOLED,
                           out + O_POOL_P + (size_t)l * NB * PB * DP, out + O_POOL_S + (size_t)l * NDEC * PB * DP);
        for (int g = 0; g < 4; ++g) gemm(stream, POOLED + g * 512, DP, w_pool + ((size_t)l * 4 + g) * 512 * 512, 512, YB + g * 512, DP, MT, 512, 512);
        hipLaunchKernelGGL(k_mix, dim3((unsigned)(((size_t)MT * DM + 255) / 256)), dim3(256), 0, stream, PROJ, b_gate + (size_t)l * 2 * DM, YA, YB, pool_scale + (size_t)l * DP, MIX);
        gemm(stream, MIX, DM, w_out + (size_t)l * DM * DM, DM, MO, DM, MT, DM, DM);
        hipLaunchKernelGGL(k_ln, dim3(MT), dim3(256), 0, stream, xin, MO, ln1_g + (size_t)l * DM, ln1_b + (size_t)l * DM, X1);
        gemm(stream, X1, DM, w_up + (size_t)l * DM * 2 * DFF, 2 * DFF, H, 2 * DFF, MT, 2 * DFF, DM);
        hipLaunchKernelGGL(k_ffn, dim3((unsigned)(((size_t)MT * DFF + 255) / 256)), dim3(256), 0, stream, H, state_ffn + (size_t)l * NDEC * 2 * 2 * DFF, fconv_w + (size_t)l * 3 * 2 * DFF,
                           fconv_b + (size_t)l * 2 * DFF, HACT, out + O_FFN_P + (size_t)l * NB * 2 * 2 * DFF, out + O_FFN_S + (size_t)l * NDEC * 2 * 2 * DFF);
        gemm(stream, HACT, DFF, w_down + (size_t)l * DFF * DM, DM, DN, DM, MT, DM, DFF);
        float* dst = (l == DEPTH - 1) ? out + O_YP : xnext;
        hipLaunchKernelGGL(k_ln, dim3(MT), dim3(256), 0, stream, X1, DN, ln2_g + (size_t)l * DM, ln2_b + (size_t)l * DM, dst);
        float* t = xin; xin = xnext; xnext = t;
    }
}
```

```cpp
#include <hip/hip_runtime.h>
#include <cstdio>
#include <cstdint>
namespace pg8 {
#define PG8_LAS __attribute__((address_space(3)))
typedef unsigned short bf16_t;
typedef short bf16x8 __attribute__((ext_vector_type(8)));
typedef float f32x4 __attribute__((ext_vector_type(4)));
typedef unsigned u32x4 __attribute__((ext_vector_type(4)));
constexpr int BM = 256, BK = 64, HALF = 128, HTB = HALF * BK * 2  , STAGE_BYTES = 8 * HTB, NXCD = 8, WGM = 8;

__host__ __device__ __forceinline__ int lds_byte(int r, int c) { const int st = (r >> 4) * 2 + (c >> 5), rr = r & 15, cc = c & 31, ob = rr * 64 + cc * 2; return st * 1024 + (ob ^ (((ob >> 9) & 1) << 5)); }
__host__ __device__ __forceinline__ void stage_rc(int b, int& R, int& C) { const int st = b / 1024, sb = b % 1024, swz = sb ^ (((sb >> 9) & 1) << 5); R = (st >> 1) * 16 + swz / 64; C = (st & 1) * 32 + (swz % 64) / 2; }
__host__ __device__ __forceinline__ int perm32(int rho) { const int n = rho >> 4, i = rho & 15; return 8 * (i >> 2) + 4 * n + (i & 3); }

struct Unit { int pm, pn; };
struct Gemm { const bf16_t* A; const bf16_t* Bt; int M, N, K, lda, ldb, agdiv, agstride; };

struct StaticOrder {
    int nM, nN, nwg, G, c;
    __host__ __device__ void init(int M, int N, int G_, int c_) { nM = M / BM; nN = N / BM; nwg = nM * nN; G = G_; c = c_; }
    __host__ __device__ bool next(int i, Unit& u) const {
        const long L = (long)i * G + c; if (L >= nwg) return false;
        int wgid = (int)L; { const int q = nwg / NXCD, r = nwg % NXCD, xcd = wgid % NXCD, off = wgid / NXCD; wgid = (xcd < r ? xcd * (q + 1) : r * (q + 1) + (xcd - r) * q) + off; }
        const int nig = WGM * nN, gid = wgid / nig, fm = gid * WGM, gsz = (nM - fm) < WGM ? (nM - fm) : WGM;
        u.pm = fm + ((wgid % nig) % gsz); u.pn = (wgid % nig) / gsz; return true;
    }
    __device__ __forceinline__ void a_ready(const Unit&) const {}
    __device__ __forceinline__ void done(const Unit&) const {}
};

__device__ __forceinline__ unsigned cvt_pk_bf16(float lo, float hi) { unsigned r; asm volatile("v_cvt_pk_bf16_f32 %0, %1, %2" : "=v"(r) : "v"(lo), "v"(hi)); return r; }
typedef float f32x2 __attribute__((ext_vector_type(2)));
__device__ __forceinline__ f32x2 gelu_pk(f32x2 v) {
    const f32x2 av = __builtin_elementwise_abs(v), d = av * 0.2316418882f + 1.0f;
    f32x2 t; t.x = __builtin_amdgcn_rcpf(d.x); t.y = __builtin_amdgcn_rcpf(d.y);
    f32x2 q = t * 0.5307027145f + (-0.7265760135f); q = q * t + 0.7107068705f; q = q * t + (-0.142248368f); q = q * t + 0.127414796f; q = q * t;
    const f32x2 s = (v * v) * (-0.72134752044f);
    f32x2 e; e.x = __builtin_amdgcn_exp2f(s.x); e.y = __builtin_amdgcn_exp2f(s.y);
    const f32x2 m = v * (q * e), r = v - m;
    f32x2 o; o.x = v.x < 0.f ? m.x : r.x; o.y = v.y < 0.f ? m.y : r.y; return o;
}

template <int ACT  > struct EpiBf16 {
    static constexpr bool PERM = true, AFTER_DRAIN = false; static_assert(ACT == 0 || ACT == 1, "EpiBf16: ACT is 0 (none) or 1 (gelu_pk)");
    bf16_t* O; int ldc; const float* bias; int split_cols; size_t split_stride; float scale0;
    __device__ __forceinline__ void operator()(const f32x4 (&acc)[2][2][4][2], const Unit& u, int wr, int wc, int fr, int fq) const {
        const int row0 = u.pm * BM + wr * 64 + fr; int colt = u.pn * BM; bf16_t* base = O;
        float sc = 1.f; if (split_cols) { const int t = colt / split_cols; base += (size_t)t * split_stride; colt -= t * split_cols; if (t == 0) sc = scale0; }
        const int col0 = colt + wc * 32 + 8 * fq, bcol0 = u.pn * BM + wc * 32 + 8 * fq;
        f32x4 bv[2][2];
#pragma unroll
        for (int bj = 0; bj < 2; ++bj)
#pragma unroll
            for (int n = 0; n < 2; ++n) bv[bj][n] = bias ? *(const f32x4*)(bias + bcol0 + bj * HALF + 4 * n) : (f32x4){0.f, 0.f, 0.f, 0.f};
#pragma unroll
        for (int ai = 0; ai < 2; ++ai)
#pragma unroll
            for (int m = 0; m < 4; ++m) { bf16_t* rowp = base + (size_t)(row0 + ai * HALF + m * 16) * ldc + col0;
#pragma unroll
                for (int bj = 0; bj < 2; ++bj) { f32x4 v0 = acc[ai][bj][m][0] + bv[bj][0], v1 = acc[ai][bj][m][1] + bv[bj][1];
                    if (ACT == 1) { f32x2 a = gelu_pk((f32x2){v0[0], v0[1]}), b = gelu_pk((f32x2){v0[2], v0[3]}), c = gelu_pk((f32x2){v1[0], v1[1]}), d = gelu_pk((f32x2){v1[2], v1[3]});
                        v0 = (f32x4){a.x, a.y, b.x, b.y}; v1 = (f32x4){c.x, c.y, d.x, d.y}; }
                    v0 = v0 * sc; v1 = v1 * sc; u32x4 w; w.x = cvt_pk_bf16(v0[0], v0[1]); w.y = cvt_pk_bf16(v0[2], v0[3]); w.z = cvt_pk_bf16(v1[0], v1[1]); w.w = cvt_pk_bf16(v1[2], v1[3]);
                    *(u32x4*)(rowp + bj * HALF) = w; } }
    }
};

template <class Epi, class Sched, bool ALIGN_EPI = false, bool SP2 = false>
__device__ __forceinline__ void gemm_phase(PG8_LAS unsigned char* lds, const Gemm g, const Sched& S, const Epi& E, const int tid) {
    const int wid = __builtin_amdgcn_readfirstlane(tid >> 6), lane = tid & 63, wr = wid >> 2, wc = wid & 3, fr = lane & 15, fq = lane >> 4;
    const int K = g.K, nt = K / BK;
    unsigned voffA[2], voffB[2];
#pragma unroll
    for (int i = 0; i < 2; ++i) { int R, C; stage_rc(tid * 16 + i * 8192, R, C); const int Rb = Epi::PERM ? ((R & ~31) + perm32(R & 31)) : R;
        voffA[i] = (unsigned)(R * g.lda + C) * 2u; voffB[i] = (unsigned)(Rb * g.ldb + C) * 2u; }
    const size_t kstep = (size_t)(BK * 2);
    const size_t hstepA = (size_t)HALF * g.lda * 2, hstepB = (size_t)HALF * g.ldb * 2;
    const size_t tstepA = 2 * hstepA, tstepB = 2 * hstepB;
    const unsigned ldsw = (unsigned)wid * 1024u;
    const int aoff = lds_byte(wr * 64 + fr, fq * 8), boff = lds_byte(wc * 32 + fr, fq * 8);
#define PG8_SA(b, h) (((b) * 2 + (h)) * HTB)
#define PG8_SB(b, h) ((4 + (b) * 2 + (h)) * HTB)
#define PG8_STAGE(bufoff, gbase, voff) do { _Pragma("unroll") for (int _i = 0; _i < 2; ++_i) \
        __builtin_amdgcn_global_load_lds((const unsigned*)((const char*)(gbase) + (voff)[_i]), (PG8_LAS unsigned*)(lds + (bufoff) + ldsw + _i * 8192), 16, 0, 0); } while (0)
#define PG8_LDA(dst, b, h) do { _Pragma("unroll") for (int m = 0; m < 4; ++m) _Pragma("unroll") for (int k = 0; k < 2; ++k) dst[m][k] = *(const PG8_LAS bf16x8*)(lds + PG8_SA(b, h) + aoff + m * 2048 + k * 1024); } while (0)
#define PG8_LDB(dst, b, h) do { _Pragma("unroll") for (int n = 0; n < 2; ++n) _Pragma("unroll") for (int k = 0; k < 2; ++k) dst[n][k] = *(const PG8_LAS bf16x8*)(lds + PG8_SB(b, h) + boff + n * 2048 + k * 1024); } while (0)
#define PG8_MMA(ai, bj, At, Bt) do { __builtin_amdgcn_s_setprio(1); _Pragma("unroll") for (int m = 0; m < 4; ++m) _Pragma("unroll") for (int n = 0; n < 2; ++n) _Pragma("unroll") for (int k = 0; k < 2; ++k) \
        acc[ai][bj][m][n] = __builtin_amdgcn_mfma_f32_16x16x32_bf16(Bt[n][k], At[m][k], acc[ai][bj][m][n], 0, 0, 0); __builtin_amdgcn_s_setprio(0); } while (0)
#define PG8_WAIT_V(n) asm volatile("s_waitcnt vmcnt(" #n ")" ::: "memory")
#define PG8_WAIT_L(n) asm volatile("s_waitcnt lgkmcnt(" #n ")" ::: "memory")
#define PG8_BAR __builtin_amdgcn_s_barrier()
#define PG8_SCHED __builtin_amdgcn_sched_barrier(0)
    Unit cur, nxt; int ui = 0;
    if (!S.next(0, cur)) return;
    f32x4 acc[2][2][4][2];
#pragma unroll
    for (int a = 0; a < 2; ++a)
#pragma unroll
        for (int b = 0; b < 2; ++b)
#pragma unroll
            for (int m = 0; m < 4; ++m)
#pragma unroll
                for (int n = 0; n < 2; ++n) acc[a][b][m][n] = (f32x4){0.f, 0.f, 0.f, 0.f};
    bf16x8 At[4][2], B0[2][2], B1[2][2];
    const char* cA = (const char*)g.A + (size_t)cur.pm * tstepA + (size_t)((cur.pn / g.agdiv) * g.agstride) * 2; const char* cB = (const char*)g.Bt + (size_t)cur.pn * tstepB;
    S.a_ready(cur);
    if constexpr (SP2) {
        PG8_STAGE(PG8_SB(0, 0), cB, voffB); PG8_STAGE(PG8_SB(0, 1), cB + hstepB, voffB); PG8_STAGE(PG8_SA(0, 0), cA, voffA); PG8_STAGE(PG8_SA(0, 1), cA + hstepA, voffA);
        if (wr == 1) PG8_BAR;
        PG8_WAIT_V(2); PG8_BAR;
        PG8_STAGE(PG8_SB(1, 0), cB + kstep, voffB); PG8_STAGE(PG8_SA(1, 0), cA + kstep, voffA); PG8_STAGE(PG8_SB(1, 1), cB + hstepB + kstep, voffB);
        PG8_WAIT_V(6); PG8_BAR;
    } else {
        PG8_STAGE(PG8_SB(0, 0), cB, voffB); PG8_STAGE(PG8_SA(0, 0), cA, voffA); PG8_STAGE(PG8_SB(0, 1), cB + hstepB, voffB); PG8_STAGE(PG8_SA(0, 1), cA + hstepA, voffA);
        if (wr == 1) PG8_BAR;
        PG8_WAIT_V(4); PG8_BAR;
        PG8_STAGE(PG8_SB(1, 0), cB + kstep, voffB); PG8_STAGE(PG8_SA(1, 0), cA + kstep, voffA); PG8_STAGE(PG8_SB(1, 1), cB + hstepB + kstep, voffB);
        PG8_WAIT_V(6); PG8_BAR;
    }
    for (;;) {
        const bool has_next = S.next(ui + 1, nxt);
        const char* nA = has_next ? (const char*)g.A + (size_t)nxt.pm * tstepA + (size_t)((nxt.pn / g.agdiv) * g.agstride) * 2 : cA; const char* nB = has_next ? (const char*)g.Bt + (size_t)nxt.pn * tstepB : cB;
        for (int t = 0; t < nt; t += 2) {
            const bool last = (t == nt - 2);
            const char* a1 = cA + (size_t)(t + 1) * kstep;
            const char* a2 = last ? nA : cA + (size_t)(t + 2) * kstep; const char* b2 = last ? nB : cB + (size_t)(t + 2) * kstep;
            const char* a3 = a2 + kstep; const char* b3 = b2 + kstep;
            if (last && has_next) S.a_ready(nxt);
            if constexpr (SP2) {
            PG8_LDB(B0, 0, 0); PG8_LDB(B1, 0, 1); PG8_SCHED; PG8_LDA(At, 0, 0); PG8_STAGE(PG8_SA(1, 1), a1 + hstepA, voffA);
            PG8_WAIT_V(8); PG8_WAIT_L(0); PG8_BAR; PG8_MMA(0, 0, At, B0); PG8_MMA(0, 1, At, B1); PG8_BAR; PG8_SCHED;
            PG8_LDA(At, 0, 1); PG8_STAGE(PG8_SB(0, 0), b2, voffB); PG8_STAGE(PG8_SB(0, 1), b2 + hstepB, voffB); PG8_STAGE(PG8_SA(0, 0), a2, voffA);
            PG8_WAIT_V(8); PG8_WAIT_L(0); PG8_BAR; PG8_MMA(1, 0, At, B0); PG8_MMA(1, 1, At, B1); PG8_BAR; PG8_SCHED;
            PG8_LDB(B0, 1, 0); PG8_LDB(B1, 1, 1); PG8_SCHED; PG8_LDA(At, 1, 0); PG8_STAGE(PG8_SA(0, 1), a2 + hstepA, voffA);
            PG8_WAIT_V(8); PG8_WAIT_L(0); PG8_BAR; PG8_MMA(0, 0, At, B0); PG8_MMA(0, 1, At, B1); PG8_BAR; PG8_SCHED;
            PG8_LDA(At, 1, 1); PG8_STAGE(PG8_SB(1, 0), b3, voffB); PG8_STAGE(PG8_SB(1, 1), b3 + hstepB, voffB); PG8_STAGE(PG8_SA(1, 0), a3, voffA);
            PG8_WAIT_V(8); PG8_WAIT_L(0); PG8_BAR; PG8_MMA(1, 0, At, B0); PG8_MMA(1, 1, At, B1); PG8_BAR; PG8_SCHED;
            } else {
            PG8_LDB(B0, 0, 0); PG8_SCHED; PG8_LDA(At, 0, 0); PG8_STAGE(PG8_SA(1, 1), a1 + hstepA, voffA);
            PG8_WAIT_L(8); PG8_BAR; PG8_WAIT_L(0); PG8_MMA(0, 0, At, B0); PG8_BAR; PG8_SCHED;
            PG8_LDB(B1, 0, 1); PG8_STAGE(PG8_SB(0, 0), b2, voffB);
            PG8_BAR; PG8_WAIT_L(0); PG8_MMA(0, 1, At, B1); PG8_BAR;
            PG8_LDA(At, 0, 1); PG8_STAGE(PG8_SA(0, 0), a2, voffA);
            PG8_BAR; PG8_WAIT_L(0); PG8_MMA(1, 0, At, B0); PG8_BAR; PG8_SCHED;
            PG8_STAGE(PG8_SB(0, 1), b2 + hstepB, voffB);
            PG8_WAIT_V(6); PG8_BAR; PG8_MMA(1, 1, At, B1); PG8_BAR;
            PG8_LDB(B0, 1, 0); PG8_SCHED; PG8_LDA(At, 1, 0); PG8_STAGE(PG8_SA(0, 1), a2 + hstepA, voffA);
            PG8_WAIT_L(8); PG8_BAR; PG8_WAIT_L(0); PG8_MMA(0, 0, At, B0); PG8_BAR; PG8_SCHED;
            PG8_LDB(B1, 1, 1); PG8_STAGE(PG8_SB(1, 0), b3, voffB);
            PG8_BAR; PG8_WAIT_L(0); PG8_MMA(0, 1, At, B1); PG8_BAR;
            PG8_LDA(At, 1, 1); PG8_STAGE(PG8_SA(1, 0), a3, voffA);
            PG8_BAR; PG8_WAIT_L(0); PG8_MMA(1, 0, At, B0); PG8_BAR; PG8_SCHED;
            PG8_STAGE(PG8_SB(1, 1), b3 + hstepB, voffB);
            PG8_WAIT_V(6); PG8_BAR; PG8_MMA(1, 1, At, B1); PG8_BAR;
            }
        }
        if constexpr (ALIGN_EPI) { if (wr == 0) PG8_BAR; }
        if constexpr (!Epi::AFTER_DRAIN) { E(acc, cur, wr, wc, fr, fq); S.done(cur); }
        if (!has_next) break;
#pragma unroll
        for (int a = 0; a < 2; ++a)
#pragma unroll
            for (int b = 0; b < 2; ++b)
#pragma unroll
                for (int m = 0; m < 4; ++m)
#pragma unroll
                    for (int n = 0; n < 2; ++n) acc[a][b][m][n] = (f32x4){0.f, 0.f, 0.f, 0.f};
        cur = nxt; cA = nA; cB = nB; ++ui;
        if constexpr (ALIGN_EPI) { if (wr == 1) PG8_BAR; }
    }
    PG8_WAIT_V(0);
    if constexpr (!ALIGN_EPI) { if (wr == 0) PG8_BAR; }
    PG8_BAR;
    if constexpr (Epi::AFTER_DRAIN) { E.fused(acc, cur, wr, wc, fr, fq, lds, wid, lane); S.done(cur); }
#undef PG8_SA
#undef PG8_SB
#undef PG8_STAGE
#undef PG8_LDA
#undef PG8_LDB
#undef PG8_MMA
#undef PG8_WAIT_V
#undef PG8_WAIT_L
#undef PG8_BAR
#undef PG8_SCHED
}
}
constexpr int DM = 2048, NB = 4, SEQ = 2048, DEPTH = 2, NDEC = 128;
constexpr int MP = NB * SEQ;
constexpr int MT = MP + NDEC;
constexpr int DI = 4096, NH = 64, HD = 64, NG = 8, DS = 128, CD = 6144;
constexpr int DP = 2048, PB = 15, DFF = 5504, DIN = 16448, NPROJ = 16384;
constexpr int OFF_Z = 0, OFF_XBC = 4096, OFF_DT = 10240, OFF_POOL = 10304, OFF_GATE = 12352;
constexpr int PC_Z = 0, PC_XBC = 4096, PC_POOL = 10240, PC_GATE = 12288;
constexpr float ALPHA = 1.4142135623730951f;
constexpr float LN_EPS = 1e-5f, RMS_EPS = 1e-5f;
constexpr int NWAVES = 8;

constexpr size_t O_YP = 0;
constexpr size_t O_YS = O_YP + (size_t)NB * SEQ * DM;
constexpr size_t O_SSM_P = O_YS + (size_t)NDEC * DM;
constexpr size_t O_CONV_P = O_SSM_P + (size_t)DEPTH * NB * NH * HD * DS;
constexpr size_t O_POOL_P = O_CONV_P + (size_t)DEPTH * NB * 3 * CD;
constexpr size_t O_FFN_P = O_POOL_P + (size_t)DEPTH * NB * PB * DP;
constexpr size_t O_SSM_S = O_FFN_P + (size_t)DEPTH * NB * 2 * 2 * DFF;
constexpr size_t O_CONV_S = O_SSM_S + (size_t)DEPTH * NDEC * NH * HD * DS;
constexpr size_t O_POOL_S = O_CONV_S + (size_t)DEPTH * NDEC * 3 * CD;
constexpr size_t O_FFN_S = O_POOL_S + (size_t)DEPTH * NDEC * PB * DP;
constexpr size_t O_END = O_FFN_S + (size_t)DEPTH * NDEC * 2 * 2 * DFF;

constexpr size_t MiB = 1u << 20;
constexpr size_t WS_CTL = 0, CTL_ZERO_BYTES = 1 * MiB;
constexpr size_t WL_WIN = 0, WL_WBR = 65 * MiB, WL_WPOOL = 81 * MiB, WL_WOUT = 83 * MiB, WL_WUP = 91 * MiB, WL_WDOWN = 134 * MiB, WL_SIZE = 156 * MiB;
constexpr size_t WS_W = 1 * MiB;
constexpr size_t WS_XB = WS_W + 2 * WL_SIZE;
constexpr size_t WS_XF = WS_XB + 33 * MiB;
constexpr size_t WS_PROJ = WS_XF + 65 * MiB;
constexpr size_t WS_DT = WS_PROJ + 260 * MiB;
constexpr size_t WS_V = WS_DT + 3 * MiB;
constexpr size_t WS_SSQ = WS_V + 65 * MiB;
constexpr size_t WS_YN = WS_SSQ + 3 * MiB;
constexpr size_t WS_POOLED = WS_YN + 65 * MiB;
constexpr size_t WS_YB = WS_POOLED + 33 * MiB;
constexpr size_t WS_MIX = WS_YB + 33 * MiB;
constexpr size_t WS_U = WS_MIX + 33 * MiB;
constexpr size_t WS_X1F = WS_U + 65 * MiB;
constexpr size_t WS_X1B = WS_X1F + 65 * MiB;
constexpr size_t WS_HPRE = WS_X1B + 33 * MiB;
constexpr size_t WS_HACT = WS_HPRE + 175 * MiB;
constexpr size_t WS_END = WS_HACT + 88 * MiB;
static_assert((size_t)DIN * DM * 2 <= 65 * MiB && (size_t)2 * DFF * DM * 2 <= 43 * MiB && (size_t)DM * DFF * 2 <= 22 * MiB, "weight map");
static_assert((size_t)MT * NPROJ * 2 <= 260 * MiB && (size_t)MT * DI * 2 <= 65 * MiB && (size_t)MT * DM * 4 <= 65 * MiB && (size_t)MT * DM * 2 <= 33 * MiB, "act map");
static_assert((size_t)MT * 2 * DFF * 2 <= 175 * MiB && (size_t)MT * DFF * 2 <= 88 * MiB && (size_t)MT * 64 * 4 <= 3 * MiB, "act map 2");
constexpr int CW_BAR = 4096;

constexpr int LDS_BYTES = 156 * 1024;
constexpr int MISC_OFF = 152 * 1024;

#define GAS __attribute__((address_space(1)))
#define LAS __attribute__((address_space(3)))
typedef unsigned short bf16;
typedef unsigned v4u __attribute__((ext_vector_type(4)));
typedef unsigned v2u __attribute__((ext_vector_type(2)));
typedef float f32x4 __attribute__((ext_vector_type(4)));
typedef short bf16x8 __attribute__((ext_vector_type(8)));
typedef short bf16x4 __attribute__((ext_vector_type(4)));
#define LDS_WAIT() asm volatile("s_waitcnt lgkmcnt(0)" ::: "memory")
#define VM_WAIT() asm volatile("s_waitcnt vmcnt(0)" ::: "memory")
__device__ __forceinline__ unsigned pk2(float lo, float hi) { return pg8::cvt_pk_bf16(lo, hi); }
__device__ __forceinline__ float bflo(unsigned u) { return __builtin_bit_cast(float, u << 16); }
__device__ __forceinline__ float bfhi(unsigned u) { return __builtin_bit_cast(float, u & 0xffff0000u); }
__device__ __forceinline__ float bf1(bf16 u) { return __builtin_bit_cast(float, (unsigned)u << 16); }
__device__ __forceinline__ f32x4 bf4(v2u u) { return (f32x4){bflo(u.x), bfhi(u.x), bflo(u.y), bfhi(u.y)}; }
__device__ __forceinline__ v2u pk4(f32x4 v) { v2u r; r.x = pk2(v[0], v[1]); r.y = pk2(v[2], v[3]); return r; }
__device__ __forceinline__ float siluf(float x) { return x / (1.f + __expf(-x)); }
__device__ __forceinline__ float sigmf(float x) { return 1.f / (1.f + __expf(-x)); }
__device__ __forceinline__ float softplusf(float x) { return x > 20.f ? x : log1pf(expf(x)); }
__device__ __forceinline__ float wave_sum(float v) {
#pragma unroll
    for (int o = 1; o < 64; o <<= 1) v += __shfl_xor(v, o);
    return v;
}

#define XB_TMO      128
#define XB_XCNT(j)  (256  + 64 * (j))
#define XB_XSUB(j)  (1280 + 64 * (j))
#define XB_XGEN(j)  (2304 + 64 * (j))
#define XB_TOP      3328
#define XB_TOPGEN   3392
#define XCD_BAR_WORDS 3456
#define XB_SPIN_CAP (1u << 18)

__device__ __forceinline__ unsigned xb_ld(unsigned* p)              { return __hip_atomic_load(p, __ATOMIC_RELAXED, __HIP_MEMORY_SCOPE_AGENT); }
__device__ __forceinline__ unsigned xb_add(unsigned* p, unsigned v) { return __hip_atomic_fetch_add(p, v, __ATOMIC_RELAXED, __HIP_MEMORY_SCOPE_AGENT); }
__device__ __forceinline__ unsigned xb_xcc_id() { return (unsigned)__builtin_amdgcn_s_getreg((3 << 11) | 20) & 0xFu; }
#define XB_SPIN(cond, bar) do { unsigned _sp = 0; while (cond) { __builtin_amdgcn_s_sleep(1); \
    if ((++_sp & 255u) == 0u) { if (xb_ld(&(bar)[XB_TMO])) break; if (_sp > XB_SPIN_CAP) { atomicAdd(&(bar)[XB_TMO], 1u); break; } } } } while (0)

struct XcdBarrier {
    unsigned* bar; unsigned x;
    volatile LAS unsigned* st;
};

__device__ __forceinline__ XcdBarrier xcd_barrier_post(unsigned* bar, volatile LAS unsigned* st) {
    XcdBarrier b; b.bar = bar; b.x = xb_xcc_id(); b.st = st;
    if (threadIdx.x == 0) (void)xb_add(&bar[XB_XCNT(b.x)], 1u);
    return b;
}
__device__ __forceinline__ void xcd_barrier_complete(unsigned* bar, unsigned x, unsigned& nloc, unsigned& nx) {
    const unsigned G = gridDim.x * gridDim.y * gridDim.z;
    unsigned sum, cnt, mine, sp = 0u;
    for (;;) {
        sum = 0u; cnt = 0u; mine = 0u;
#pragma unroll
        for (unsigned j = 0; j < 16; ++j) { const unsigned c = xb_ld(&bar[XB_XCNT(j)]); sum += c; cnt += (c > 0u) ? 1u : 0u; mine = (j == x) ? c : mine; }
        if (sum == G) break;
        __builtin_amdgcn_s_sleep(1);
        if ((++sp & 255u) == 0u) { if (xb_ld(&bar[XB_TMO])) break; if (sp > XB_SPIN_CAP) { atomicAdd(&bar[XB_TMO], 1u); break; } }
    }
    nloc = mine > 0u ? mine : 1u; nx = cnt > 0u ? cnt : 1u;
}

__device__ __forceinline__ void xcd_barrier(const XcdBarrier& b) {
    asm volatile("s_waitcnt vmcnt(0)" ::: "memory");
    __syncthreads();
    if (threadIdx.x == 0) {
        unsigned* bar = b.bar;
        __builtin_amdgcn_s_waitcnt(0);
        unsigned nloc = b.st[0], nx = b.st[1];
        if (nloc == 0u) { xcd_barrier_complete(bar, b.x, nloc, nx); b.st[0] = nloc; b.st[1] = nx; }
        const unsigned old = xb_add(&bar[XB_XSUB(b.x)], 1u);
        const unsigned gen = old / nloc;
        if (old + 1u == (gen + 1u) * nloc) {
            __builtin_amdgcn_fence(__ATOMIC_RELEASE, "agent");
            asm volatile("s_waitcnt vmcnt(0)" ::: "memory");
            const unsigned og = xb_add(&bar[XB_TOP], 1u);
            const unsigned tg = og / nx;
            if (og + 1u == (tg + 1u) * nx) xb_add(&bar[XB_TOPGEN], 1u);
            else XB_SPIN(xb_ld(&bar[XB_TOPGEN]) == tg, bar);
            __builtin_amdgcn_fence(__ATOMIC_ACQUIRE, "agent");
            xb_add(&bar[XB_XGEN(b.x)], 1u);
            asm volatile("s_waitcnt vmcnt(0)" ::: "memory");
        } else {
            XB_SPIN(xb_ld(&bar[XB_XGEN(b.x)]) == gen, bar);
            __builtin_amdgcn_fence(__ATOMIC_ACQUIRE, "agent");
            asm volatile("s_waitcnt vmcnt(0)" ::: "memory");
        }
    }
    __syncthreads();
}


struct RowSrc { const float* p; const float* s; __device__ __forceinline__ const float* at(int row) const { return row < MP ? p + (size_t)row * DM : s + (size_t)(row - MP) * DM; } };

template <class F> struct Epi4 {
    static constexpr bool PERM = false, AFTER_DRAIN = false; F f;
    __device__ __forceinline__ void operator()(const pg8::f32x4 (&acc)[2][2][4][2], const pg8::Unit& u, int wr, int wc, int fr, int fq) const {
        const int row0 = u.pm * 256 + wr * 64 + fr, col0 = u.pn * 256 + wc * 32 + 4 * fq;
#pragma unroll
        for (int ai = 0; ai < 2; ++ai)
#pragma unroll
            for (int m = 0; m < 4; ++m)
#pragma unroll
                for (int bj = 0; bj < 2; ++bj)
#pragma unroll
                    for (int n = 0; n < 2; ++n) f(row0 + ai * 128 + m * 16, col0 + bj * 128 + n * 16, acc[ai][bj][m][n]);
    }
};
struct FProj { bf16* PROJ; float* DT;
    __device__ __forceinline__ void operator()(int row, int col, f32x4 v) const {
        if (col < NPROJ) *(v2u*)(PROJ + (size_t)row * NPROJ + col) = pk4(v);
        else *(f32x4*)(DT + (size_t)row * 64 + (col - NPROJ)) = v; } };
struct FYb { const float* scale; bf16* YB;
    __device__ __forceinline__ void operator()(int row, int col, f32x4 v) const {
        const f32x4 s = *(const f32x4*)(scale + col); *(v2u*)(YB + (size_t)row * DM + col) = pk4(v * s); } };
struct FMix { const bf16* PROJ; const float* bg; const bf16* YB; bf16* MIX;
    __device__ __forceinline__ void operator()(int row, int col, f32x4 v) const {
        const f32x4 ga = bf4(*(const v2u*)(PROJ + (size_t)row * NPROJ + PC_GATE + col)) + *(const f32x4*)(bg + col);
        const f32x4 gb = bf4(*(const v2u*)(PROJ + (size_t)row * NPROJ + PC_GATE + DM + col)) + *(const f32x4*)(bg + DM + col);
        const f32x4 yb = bf4(*(const v2u*)(YB + (size_t)row * DM + col));
        f32x4 o;
#pragma unroll
        for (int e = 0; e < 4; ++e) o[e] = sigmf(ga[e]) * v[e] + sigmf(gb[e]) * yb[e];
        *(v2u*)(MIX + (size_t)row * DM + col) = pk4(o); } };
struct FRes { RowSrc x; float* U;
    __device__ __forceinline__ void operator()(int row, int col, f32x4 v) const {
        const f32x4 xr = *(const f32x4*)(x.at(row) + col); *(f32x4*)(U + (size_t)row * DM + col) = xr * ALPHA + v; } };
struct FBf { bf16* O; int ldc;
    __device__ __forceinline__ void operator()(int row, int col, f32x4 v) const { *(v2u*)(O + (size_t)row * ldc + col) = pk4(v); } };

template <int NT, class F>
__device__ __forceinline__ void skinny_unit(LAS unsigned char* lds, const bf16* A, int lda, const bf16* Bt, int ldb, int K, int row0, int col0, const F& f, int wave, int lane) {
    const int l15 = lane & 15, g4 = lane >> 4;
    f32x4 acc[8][NT];
#pragma unroll
    for (int rt = 0; rt < 8; ++rt)
#pragma unroll
        for (int ct = 0; ct < NT; ++ct) acc[rt][ct] = (f32x4){0.f, 0.f, 0.f, 0.f};
    const int nsteps = K / 32;
    const bf16* ap = A + (size_t)l15 * lda + 8 * g4;
    const bf16* bp = Bt + (size_t)l15 * ldb + 8 * g4;
#pragma unroll 2
    for (int s = wave; s < nsteps; s += 8) {
        bf16x8 af[8], bfr[NT];
#pragma unroll
        for (int rt = 0; rt < 8; ++rt) af[rt] = *(const bf16x8*)(ap + (size_t)rt * 16 * lda + 32 * s);
#pragma unroll
        for (int ct = 0; ct < NT; ++ct) bfr[ct] = *(const bf16x8*)(bp + (size_t)ct * 16 * ldb + 32 * s);
#pragma unroll
        for (int rt = 0; rt < 8; ++rt)
#pragma unroll
            for (int ct = 0; ct < NT; ++ct) acc[rt][ct] = __builtin_amdgcn_mfma_f32_16x16x32_bf16(bfr[ct], af[rt], acc[rt][ct], 0, 0, 0);
    }
    constexpr int PITCH = 16 * NT * 4 + 16, SLOT = 128 * PITCH, NBATCH = (NT == 4) ? 2 : 1, WPB = 8 / NBATCH;
    f32x4 r[NT];
#pragma unroll
    for (int ct = 0; ct < NT; ++ct) r[ct] = (f32x4){0.f, 0.f, 0.f, 0.f};
#pragma unroll
    for (int batch = 0; batch < NBATCH; ++batch) {
        if (wave / WPB == batch) {
#pragma unroll
            for (int rt = 0; rt < 8; ++rt)
#pragma unroll
                for (int ct = 0; ct < NT; ++ct) *(LAS f32x4*)(lds + (wave % WPB) * SLOT + (16 * rt + l15) * PITCH + (16 * ct + 4 * g4) * 4) = acc[rt][ct];
        }
        __syncthreads();
#pragma unroll
        for (int slot = 0; slot < WPB; ++slot)
#pragma unroll
            for (int ct = 0; ct < NT; ++ct) r[ct] += *(const LAS f32x4*)(lds + slot * SLOT + (16 * wave + l15) * PITCH + (16 * ct + 4 * g4) * 4);
        __syncthreads();
    }
#pragma unroll
    for (int ct = 0; ct < NT; ++ct) f(row0 + 16 * wave + l15, col0 + 16 * ct + 4 * g4, r[ct]);
}

__device__ __forceinline__ void transpose_item(const float* src, int lds_, int col0, int K, bf16* dst, int drow0, const float* kscale, int ntn, int item, LAS float* scr, int lane) {
    const int kb = item / ntn, nb = item % ntn, k0 = 64 * kb, n0 = 64 * nb;
    f32x4 v[16];
#pragma unroll
    for (int i = 0; i < 16; ++i) { const int kr = 4 * i + (lane >> 4); v[i] = *(const f32x4*)(src + (size_t)(k0 + kr) * lds_ + col0 + n0 + 4 * (lane & 15)); }
    if (kscale) {
#pragma unroll
        for (int i = 0; i < 16; ++i) v[i] = v[i] * kscale[k0 + 4 * i + (lane >> 4)];
    }
#pragma unroll
    for (int i = 0; i < 16; ++i) { LAS float* d = scr + (4 * i + (lane >> 4)) * 65 + 4 * (lane & 15); d[0] = v[i][0]; d[1] = v[i][1]; d[2] = v[i][2]; d[3] = v[i][3]; }
    LDS_WAIT(); asm volatile("" ::: "memory");
    const int c = lane & 7;
#pragma unroll
    for (int j = 0; j < 8; ++j) { const int n = (lane >> 3) + 8 * j; const LAS float* s = scr + (8 * c) * 65 + n;
        v4u o; o.x = pk2(s[0 * 65], s[1 * 65]); o.y = pk2(s[2 * 65], s[3 * 65]); o.z = pk2(s[4 * 65], s[5 * 65]); o.w = pk2(s[6 * 65], s[7 * 65]);
        *(v4u*)(dst + (size_t)(drow0 + n0 + n) * K + k0 + 8 * c) = o; }
    LDS_WAIT(); asm volatile("" ::: "memory");
}

struct Args { const float* in[26]; float* out; unsigned char* ws; int ph_lo, ph_hi; };
__device__ __forceinline__ const Args& fresh_args() {
    auto p = __builtin_amdgcn_kernarg_segment_ptr();
    asm volatile("" : "+s"(p));
    return *(const Args*)p;
}

__device__ __forceinline__ void p0_prologue(const Args& a, LAS unsigned char* lds, int gw, int NGW, int gt, int NGT, int wave, int lane) {
    LAS float* scr = (LAS float*)(lds + wave * 16640);
    constexpr int I_INA = 32 * 160, I_INB = 32 * 1, I_INC = 32 * 96, I_BR = 64 * 32, I_PL = 8 * 8, I_OUT = 32 * 32, I_UP = 32 * 172, I_DN = 86 * 32;
    constexpr int PER_LAYER = I_INA + I_INB + I_INC + I_BR + 4 * I_PL + I_OUT + I_UP + I_DN;
    for (int it = gw; it < 2 * PER_LAYER; it += NGW) {
        const int l = it / PER_LAYER; int r = it % PER_LAYER;
        unsigned char* wl = a.ws + WS_W + (size_t)l * WL_SIZE;
        const float* w_in = a.in[6] + (size_t)l * DM * DIN;
        if (r < I_INA) { transpose_item(w_in, DIN, 0, DM, (bf16*)(wl + WL_WIN), 0, nullptr, 160, r, scr, lane); continue; } r -= I_INA;
        if (r < I_INB) { transpose_item(w_in, DIN, OFF_DT, DM, (bf16*)(wl + WL_WIN), NPROJ, nullptr, 1, r, scr, lane); continue; } r -= I_INB;
        if (r < I_INC) { transpose_item(w_in, DIN, OFF_POOL, DM, (bf16*)(wl + WL_WIN), PC_POOL, nullptr, 96, r, scr, lane); continue; } r -= I_INC;
        if (r < I_BR) { transpose_item(a.in[14] + (size_t)l * DI * DM, DM, 0, DI, (bf16*)(wl + WL_WBR), 0, a.in[13] + (size_t)l * DI, 32, r, scr, lane); continue; } r -= I_BR;
        if (r < 4 * I_PL) { const int g = r / I_PL; transpose_item(a.in[15] + ((size_t)l * 4 + g) * 512 * 512, 512, 0, 512, (bf16*)(wl + WL_WPOOL), g * 512, nullptr, 8, r % I_PL, scr, lane); continue; } r -= 4 * I_PL;
        if (r < I_OUT) { transpose_item(a.in[17] + (size_t)l * DM * DM, DM, 0, DM, (bf16*)(wl + WL_WOUT), 0, nullptr, 32, r, scr, lane); continue; } r -= I_OUT;
        if (r < I_UP) { transpose_item(a.in[20] + (size_t)l * DM * 2 * DFF, 2 * DFF, 0, DM, (bf16*)(wl + WL_WUP), 0, nullptr, 172, r, scr, lane); continue; } r -= I_UP;
        transpose_item(a.in[23] + (size_t)l * DFF * DM, DM, 0, DFF, (bf16*)(wl + WL_WDOWN), 0, nullptr, 32, r, scr, lane);
    }
    bf16* XB = (bf16*)(a.ws + WS_XB);
    for (int i = gt; i < MT * (DM / 8); i += NGT) {
        const int row = i / (DM / 8), c8 = (i % (DM / 8)) * 8;
        const float* src = (row < MP ? a.in[0] + (size_t)row * DM : a.in[1] + (size_t)(row - MP) * DM) + c8;
        const f32x4 v0 = *(const f32x4*)src, v1 = *(const f32x4*)(src + 4);
        v4u o; o.x = pk2(v0[0], v0[1]); o.y = pk2(v0[2], v0[3]); o.z = pk2(v1[0], v1[1]); o.w = pk2(v1[2], v1[3]);
        *(v4u*)(XB + (size_t)row * DM + c8) = o;
    }
}

constexpr int SP = 272;
constexpr int L_CM = 0, L_BM = 128 * SP, L_BWT = 2 * 128 * SP, L_XT = 3 * 128 * SP, L_SB = L_XT + 64 * SP, L_DTV = L_SB + 64 * SP, L_ACUM = L_DTV + 512, L_SSD_END = L_ACUM + 512;
static_assert(L_SSD_END <= MISC_OFF, "SSD LDS map");

__device__ __forceinline__ void conv_pair_run(const bf16* projseq  , int pcol  , int t0  ,
                                              const float* cw  , const float* cb, int wcol  , float (&o0)[8], float (&o1)[8]) {
    float v0[11], v1[11];
#pragma unroll
    for (int k = 0; k < 11; ++k) { const int t = t0 - 3 + k; unsigned u = 0u; if (t >= 0) u = *(const unsigned*)(projseq + (size_t)t * NPROJ + pcol); v0[k] = bflo(u); v1[k] = bfhi(u); }
    float w0[4], w1[4];
#pragma unroll
    for (int j = 0; j < 4; ++j) { const float2 w = *(const float2*)(cw + (size_t)j * CD + wcol); w0[j] = w.x; w1[j] = w.y; }
    const float2 bb = *(const float2*)(cb + wcol);
#pragma unroll
    for (int e = 0; e < 8; ++e) {
        float y0 = bb.x, y1 = bb.y;
#pragma unroll
        for (int j = 0; j < 4; ++j) { y0 = fmaf(w0[j], v0[e + j], y0); y1 = fmaf(w1[j], v1[e + j], y1); }
        o0[e] = siluf(y0); o1[e] = siluf(y1);
    }
}

__device__ __forceinline__ void ssd_prompt_unit(const Args& a, LAS unsigned char* lds, int l, int b, int h, int tid, int wave, int lane) {
    const bf16* PROJ = (const bf16*)(a.ws + WS_PROJ); const float* DT = (const float*)(a.ws + WS_DT);
    bf16* V = (bf16*)(a.ws + WS_V); float* SSQ = (float*)(a.ws + WS_SSQ);
    const float* cw = a.in[8] + (size_t)l * 4 * CD; const float* cb = a.in[9] + (size_t)l * CD;
    const float a_h = -expf(a.in[11][l * NH + h]), dtb = a.in[10][l * NH + h], Dh = a.in[12][l * NH + h];
    const int g = h >> 3, l15 = lane & 15, g4 = lane >> 4;
    const bf16* projseq = PROJ + (size_t)b * SEQ * NPROJ;
    LAS float* dtv = (LAS float*)(lds + L_DTV); LAS float* acum = (LAS float*)(lds + L_ACUM);
    f32x4 sacc[4];
#pragma unroll
    for (int pt = 0; pt < 4; ++pt) sacc[pt] = (f32x4){0.f, 0.f, 0.f, 0.f};
    for (int i = tid; i < 64 * SP / 4; i += 512) ((LAS unsigned*)(lds + L_SB))[i] = 0u;
    for (int c = 0; c < SEQ / 128; ++c) {
        const int tc = c * 128;
        if (wave == 0) {
            const float d0 = softplusf(DT[(size_t)(b * SEQ + tc + 2 * lane) * 64 + h] + dtb), d1 = softplusf(DT[(size_t)(b * SEQ + tc + 2 * lane + 1) * 64 + h] + dtb);
            const float a0 = d0 * a_h, a1 = d1 * a_h; float s = a0 + a1;
#pragma unroll
            for (int o = 1; o < 64; o <<= 1) { const float t = __shfl_up(s, o); if (lane >= o) s += t; }
            dtv[2 * lane] = d0; dtv[2 * lane + 1] = d1; acum[2 * lane] = s - a1; acum[2 * lane + 1] = s;
        }
        __syncthreads();
        const float aend = acum[127];
        {
            const int cp = tid & 31, rn = tid >> 5; float o0[8], o1[8];
            conv_pair_run(projseq, PC_XBC + h * HD + 2 * cp, tc + 8 * rn, cw, cb, h * HD + 2 * cp, o0, o1);
            v4u w0, w1; w0.x = pk2(o0[0], o0[1]); w0.y = pk2(o0[2], o0[3]); w0.z = pk2(o0[4], o0[5]); w0.w = pk2(o0[6], o0[7]);
            w1.x = pk2(o1[0], o1[1]); w1.y = pk2(o1[2], o1[3]); w1.z = pk2(o1[4], o1[5]); w1.w = pk2(o1[6], o1[7]);
            *(LAS v4u*)(lds + L_XT + (2 * cp) * SP + 16 * rn) = w0; *(LAS v4u*)(lds + L_XT + (2 * cp + 1) * SP + 16 * rn) = w1;
        }
#pragma unroll
        for (int k = 0; k < 2; ++k) {
            const int idx = tid + 512 * k, cp = idx & 63, rn = idx >> 6; float o0[8], o1[8];
            conv_pair_run(projseq, PC_XBC + DI + g * DS + 2 * cp, tc + 8 * rn, cw, cb, DI + g * DS + 2 * cp, o0, o1);
            float wj[8];
#pragma unroll
            for (int e = 0; e < 8; ++e) { const int j = 8 * rn + e; wj[e] = dtv[j] * __expf(aend - acum[j]); }
#pragma unroll
            for (int e = 0; e < 8; ++e) *(LAS unsigned*)(lds + L_BM + (8 * rn + e) * SP + 4 * cp) = pk2(o0[e], o1[e]);
            v4u w0, w1; w0.x = pk2(o0[0] * wj[0], o0[1] * wj[1]); w0.y = pk2(o0[2] * wj[2], o0[3] * wj[3]); w0.z = pk2(o0[4] * wj[4], o0[5] * wj[5]); w0.w = pk2(o0[6] * wj[6], o0[7] * wj[7]);
            w1.x = pk2(o1[0] * wj[0], o1[1] * wj[1]); w1.y = pk2(o1[2] * wj[2], o1[3] * wj[3]); w1.z = pk2(o1[4] * wj[4], o1[5] * wj[5]); w1.w = pk2(o1[6] * wj[6], o1[7] * wj[7]);
            *(LAS v4u*)(lds + L_BWT + (2 * cp) * SP + 16 * rn) = w0; *(LAS v4u*)(lds + L_BWT + (2 * cp + 1) * SP + 16 * rn) = w1;
        }
#pragma unroll
        for (int k = 0; k < 2; ++k) {
            const int idx = tid + 512 * k, cp = idx & 63, rn = idx >> 6; float o0[8], o1[8];
            conv_pair_run(projseq, PC_XBC + DI + NG * DS + g * DS + 2 * cp, tc + 8 * rn, cw, cb, DI + NG * DS + g * DS + 2 * cp, o0, o1);
#pragma unroll
            for (int e = 0; e < 8; ++e) *(LAS unsigned*)(lds + L_CM + (8 * rn + e) * SP + 4 * cp) = pk2(o0[e], o1[e]);
        }
        __syncthreads();
        {
            const int w = wave;
            bf16x8 cf[4];
#pragma unroll
            for (int ks = 0; ks < 4; ++ks) cf[ks] = *(const LAS bf16x8*)(lds + L_CM + (16 * w + l15) * SP + (32 * ks + 8 * g4) * 2);
            const float ai = acum[16 * w + l15];
            f32x4 gt[8];
#pragma unroll
            for (int jt = 0; jt < 8; ++jt) {
                gt[jt] = (f32x4){0.f, 0.f, 0.f, 0.f};
                if (jt <= w) {
                    f32x4 acc = (f32x4){0.f, 0.f, 0.f, 0.f};
#pragma unroll
                    for (int ks = 0; ks < 4; ++ks) { const bf16x8 bfr = *(const LAS bf16x8*)(lds + L_BM + (16 * jt + l15) * SP + (32 * ks + 8 * g4) * 2);
                        acc = __builtin_amdgcn_mfma_f32_16x16x32_bf16(bfr, cf[ks], acc, 0, 0, 0); }
                    const f32x4 aj = *(const LAS f32x4*)(acum + 16 * jt + 4 * g4), dj = *(const LAS f32x4*)(dtv + 16 * jt + 4 * g4);
#pragma unroll
                    for (int e = 0; e < 4; ++e) { const bool ok = (16 * jt + 4 * g4 + e) <= (16 * w + l15); gt[jt][e] = ok ? acc[e] * __expf(ai - aj[e]) * dj[e] : 0.f; }
                }
            }
            f32x4 ya[4];
            const float eai = __expf(ai);
#pragma unroll
            for (int pt = 0; pt < 4; ++pt) {
                f32x4 acc = (f32x4){0.f, 0.f, 0.f, 0.f};
#pragma unroll
                for (int ks = 0; ks < 4; ++ks) { const bf16x8 sf = *(const LAS bf16x8*)(lds + L_SB + (16 * pt + l15) * SP + (32 * ks + 8 * g4) * 2);
                    acc = __builtin_amdgcn_mfma_f32_16x16x32_bf16(sf, cf[ks], acc, 0, 0, 0); }
                ya[pt] = acc * eai;
            }
#pragma unroll
            for (int s = 0; s < 4; ++s) {
                if (2 * s <= w) {
                    bf16x8 mf; { const v2u lo = pk4(gt[2 * s]), hi = pk4(gt[2 * s + 1]); v4u m; m.x = lo.x; m.y = lo.y; m.z = hi.x; m.w = hi.y; mf = __builtin_bit_cast(bf16x8, m); }
#pragma unroll
                    for (int pt = 0; pt < 4; ++pt) {
                        const v2u lo = *(const LAS v2u*)(lds + L_XT + (16 * pt + l15) * SP + (32 * s + 4 * g4) * 2), hi = *(const LAS v2u*)(lds + L_XT + (16 * pt + l15) * SP + (32 * s + 16 + 4 * g4) * 2);
                        v4u x; x.x = lo.x; x.y = lo.y; x.z = hi.x; x.w = hi.y;
                        ya[pt] = __builtin_amdgcn_mfma_f32_16x16x32_bf16(__builtin_bit_cast(bf16x8, x), mf, ya[pt], 0, 0, 0);
                    }
                }
            }
            const size_t r = (size_t)b * SEQ + tc + 16 * w + l15;
            float ss = 0.f;
#pragma unroll
            for (int pt = 0; pt < 4; ++pt) {
                const f32x4 z = bf4(*(const v2u*)(PROJ + r * NPROJ + PC_Z + h * HD + 16 * pt + 4 * g4));
                f32x4 v;
#pragma unroll
                for (int e = 0; e < 4; ++e) { const float xv = bf1(*(const LAS bf16*)(lds + L_XT + (16 * pt + 4 * g4 + e) * SP + (16 * w + l15) * 2));
                    v[e] = (ya[pt][e] + Dh * xv) * siluf(z[e]); ss += v[e] * v[e]; }
                *(v2u*)(V + r * DI + h * HD + 16 * pt + 4 * g4) = pk4(v);
            }
            ss += __shfl_xor(ss, 16); ss += __shfl_xor(ss, 32);
            if (g4 == 0) SSQ[r * 64 + h] = ss;
        }
        __syncthreads();
        {
            const float dec = __expf(aend);
#pragma unroll
            for (int pt = 0; pt < 4; ++pt) sacc[pt] = sacc[pt] * dec;
#pragma unroll
            for (int ks = 0; ks < 4; ++ks) {
                const bf16x8 bw = *(const LAS bf16x8*)(lds + L_BWT + (16 * wave + l15) * SP + (32 * ks + 8 * g4) * 2);
#pragma unroll
                for (int pt = 0; pt < 4; ++pt) { const bf16x8 xf = *(const LAS bf16x8*)(lds + L_XT + (16 * pt + l15) * SP + (32 * ks + 8 * g4) * 2);
                    sacc[pt] = __builtin_amdgcn_mfma_f32_16x16x32_bf16(bw, xf, sacc[pt], 0, 0, 0); }
            }
#pragma unroll
            for (int pt = 0; pt < 4; ++pt) *(LAS v2u*)(lds + L_SB + (16 * pt + l15) * SP + (16 * wave + 4 * g4) * 2) = pk4(sacc[pt]);
        }
        __syncthreads();
    }
    float* so = a.out + O_SSM_P + (((size_t)l * NB + b) * NH + h) * HD * DS;
#pragma unroll
    for (int pt = 0; pt < 4; ++pt) *(f32x4*)(so + (size_t)(16 * pt + l15) * DS + 16 * wave + 4 * g4) = sacc[pt];
}

__device__ __forceinline__ f32x4 conv_vec4_dec(const float* stc  , const bf16* prow  , const float* cw, const float* cb, int ch) {
    f32x4 y = *(const f32x4*)(cb + ch);
#pragma unroll
    for (int j = 0; j < 3; ++j) y += *(const f32x4*)(cw + (size_t)j * CD + ch) * *(const f32x4*)(stc + (size_t)j * CD + ch);
    y += *(const f32x4*)(cw + (size_t)3 * CD + ch) * bf4(*(const v2u*)(prow + PC_XBC + ch));
    f32x4 o;
#pragma unroll
    for (int e = 0; e < 4; ++e) o[e] = siluf(y[e]);
    return o;
}
__device__ __forceinline__ void ssd_decode_pair(const Args& a, int l, int s, int h, int lane) {
    const bf16* PROJ = (const bf16*)(a.ws + WS_PROJ); const float* DT = (const float*)(a.ws + WS_DT);
    bf16* V = (bf16*)(a.ws + WS_V); float* SSQ = (float*)(a.ws + WS_SSQ);
    const float* cw = a.in[8] + (size_t)l * 4 * CD; const float* cb = a.in[9] + (size_t)l * CD;
    const float a_h = -expf(a.in[11][l * NH + h]), dtb = a.in[10][l * NH + h], Dh = a.in[12][l * NH + h];
    const int g = h >> 3, r = MP + s, n4 = 4 * (lane & 31);
    const float* stc = a.in[3] + ((size_t)l * NDEC + s) * 3 * CD;
    const bf16* prow = PROJ + (size_t)r * NPROJ;
    float xc;
    { const int ch = h * HD + lane; float y = cb[ch];
#pragma unroll
      for (int j = 0; j < 3; ++j) y = fmaf(cw[(size_t)j * CD + ch], stc[(size_t)j * CD + ch], y);
      y = fmaf(cw[(size_t)3 * CD + ch], bf1(prow[PC_XBC + ch]), y); xc = siluf(y); }
    const f32x4 B4 = conv_vec4_dec(stc, prow, cw, cb, DI + g * DS + n4);
    const f32x4 C4 = conv_vec4_dec(stc, prow, cw, cb, DI + NG * DS + g * DS + n4);
    const float dt = softplusf(DT[(size_t)r * 64 + h] + dtb), dA = __expf(dt * a_h);
    const float* sin = a.in[2] + (((size_t)l * NDEC + s) * NH + h) * HD * DS;
    float* sout = a.out + O_SSM_S + (((size_t)l * NDEC + s) * NH + h) * HD * DS;
    float yv = 0.f;
#pragma unroll 8
    for (int it = 0; it < 32; ++it) {
        const int p = it + (lane & 32);
        f32x4 S4 = *(const f32x4*)(sin + (size_t)p * DS + n4);
        const float xp = __shfl(xc, p);
        S4 = S4 * dA + B4 * (dt * xp);
        float part = (C4[0] * S4[0] + C4[1] * S4[1]) + (C4[2] * S4[2] + C4[3] * S4[3]);
        *(f32x4*)(sout + (size_t)p * DS + n4) = S4;
#pragma unroll
        for (int o = 1; o < 32; o <<= 1) part += __shfl_xor(part, o);
        if ((lane & 31) == it) yv = part;
    }
    const float z = bf1(prow[PC_Z + h * HD + lane]);
    const float v = (yv + Dh * xc) * siluf(z);
    const float ss = wave_sum(v * v);
    if (lane == 0) SSQ[(size_t)r * 64 + h] = ss;
    V[(size_t)r * DI + h * HD + lane] = (bf16)(pk2(v, 0.f) & 0xffffu);
}

__device__ __forceinline__ void phase_b2(const Args& a, int l, int gt, int NGT) {
    const bf16* PROJ = (const bf16*)(a.ws + WS_PROJ); const bf16* V = (const bf16*)(a.ws + WS_V); const float* SSQ = (const float*)(a.ws + WS_SSQ);
    bf16* YN = (bf16*)(a.ws + WS_YN); bf16* POOLED = (bf16*)(a.ws + WS_POOLED);
    for (int i = gt; i < MT * (DI / 8); i += NGT) {
        const int row = i >> 9, c8 = (i & 511) * 8, grp = c8 >> 9;
        const f32x4 q0 = *(const f32x4*)(SSQ + (size_t)row * 64 + grp * 8), q1 = *(const f32x4*)(SSQ + (size_t)row * 64 + grp * 8 + 4);
        const float rstd = rsqrtf(((q0[0] + q0[1]) + (q0[2] + q0[3]) + (q1[0] + q1[1]) + (q1[2] + q1[3])) * (1.f / 512.f) + RMS_EPS);
        const v4u u = *(const v4u*)(V + (size_t)row * DI + c8);
        v4u o; o.x = pk2(bflo(u.x) * rstd, bfhi(u.x) * rstd); o.y = pk2(bflo(u.y) * rstd, bfhi(u.y) * rstd); o.z = pk2(bflo(u.z) * rstd, bfhi(u.z) * rstd); o.w = pk2(bflo(u.w) * rstd, bfhi(u.w) * rstd);
        *(v4u*)(YN + (size_t)row * DI + c8) = o;
    }
    const float* stp = a.in[4] + (size_t)l * NDEC * PB * DP;
    float* op = a.out + O_POOL_P + (size_t)l * NB * PB * DP; float* os = a.out + O_POOL_S + (size_t)l * NDEC * PB * DP;
    for (int i = gt; i < MT * (DP / 8); i += NGT) {
        const int row = i >> 8, c8 = (i & 255) * 8, win = 2 << (c8 >> 9);
        const v4u uu = *(const v4u*)(PROJ + (size_t)row * NPROJ + PC_POOL + c8);
        float u[8] = {bflo(uu.x), bfhi(uu.x), bflo(uu.y), bfhi(uu.y), bflo(uu.z), bfhi(uu.z), bflo(uu.w), bfhi(uu.w)};
        float sum[8];
#pragma unroll
        for (int e = 0; e < 8; ++e) sum[e] = u[e];
        int cnt;
        if (row < MP) {
            const int t = row & (SEQ - 1); cnt = (t + 1 < win) ? t + 1 : win;
            for (int k = 1; k < cnt; ++k) { const v4u w = *(const v4u*)(PROJ + (size_t)(row - k) * NPROJ + PC_POOL + c8);
                sum[0] += bflo(w.x); sum[1] += bfhi(w.x); sum[2] += bflo(w.y); sum[3] += bfhi(w.y); sum[4] += bflo(w.z); sum[5] += bfhi(w.z); sum[6] += bflo(w.w); sum[7] += bfhi(w.w); }
            if (t >= SEQ - PB) { float* o = op + ((size_t)(row >> 11) * PB + (t - (SEQ - PB))) * DP + c8; *(f32x4*)o = (f32x4){u[0], u[1], u[2], u[3]}; *(f32x4*)(o + 4) = (f32x4){u[4], u[5], u[6], u[7]}; }
        } else {
            const int s = row - MP; cnt = win;
            for (int k = 1; k < win; ++k) { const float* sp = stp + ((size_t)s * PB + (PB - k)) * DP + c8; const f32x4 w0 = *(const f32x4*)sp, w1 = *(const f32x4*)(sp + 4);
                sum[0] += w0[0]; sum[1] += w0[1]; sum[2] += w0[2]; sum[3] += w0[3]; sum[4] += w1[0]; sum[5] += w1[1]; sum[6] += w1[2]; sum[7] += w1[3]; }
            for (int j = 0; j < PB - 1; ++j) { const float* sp = stp + ((size_t)s * PB + j + 1) * DP + c8; float* o = os + ((size_t)s * PB + j) * DP + c8; *(f32x4*)o = *(const f32x4*)sp; *(f32x4*)(o + 4) = *(const f32x4*)(sp + 4); }
            float* o = os + ((size_t)s * PB + PB - 1) * DP + c8; *(f32x4*)o = (f32x4){u[0], u[1], u[2], u[3]}; *(f32x4*)(o + 4) = (f32x4){u[4], u[5], u[6], u[7]};
        }
        const float inv = 1.f / (float)cnt;
        v4u o; o.x = pk2(sum[0] * inv - u[0], sum[1] * inv - u[1]); o.y = pk2(sum[2] * inv - u[2], sum[3] * inv - u[3]); o.z = pk2(sum[4] * inv - u[4], sum[5] * inv - u[5]); o.w = pk2(sum[6] * inv - u[6], sum[7] * inv - u[7]);
        *(v4u*)(POOLED + (size_t)row * DP + c8) = o;
    }
    const float* stc = a.in[3] + (size_t)l * NDEC * 3 * CD;
    float* ocp = a.out + O_CONV_P + (size_t)l * NB * 3 * CD; float* ocs = a.out + O_CONV_S + (size_t)l * NDEC * 3 * CD;
    for (int i = gt; i < (NB + NDEC) * 3 * (CD / 8); i += NGT) {
        const int c8 = (i % (CD / 8)) * 8, j = (i / (CD / 8)) % 3, q = i / (3 * (CD / 8));
        f32x4 v0, v1; float* o;
        if (q < NB) { const v4u w = *(const v4u*)(PROJ + (size_t)(q * SEQ + SEQ - 3 + j) * NPROJ + PC_XBC + c8); v0 = (f32x4){bflo(w.x), bfhi(w.x), bflo(w.y), bfhi(w.y)}; v1 = (f32x4){bflo(w.z), bfhi(w.z), bflo(w.w), bfhi(w.w)};
            o = ocp + ((size_t)q * 3 + j) * CD + c8; }
        else { const int s = q - NB; o = ocs + ((size_t)s * 3 + j) * CD + c8;
            if (j < 2) { const float* sp = stc + ((size_t)s * 3 + j + 1) * CD + c8; v0 = *(const f32x4*)sp; v1 = *(const f32x4*)(sp + 4); }
            else { const v4u w = *(const v4u*)(PROJ + (size_t)(MP + s) * NPROJ + PC_XBC + c8); v0 = (f32x4){bflo(w.x), bfhi(w.x), bflo(w.y), bfhi(w.y)}; v1 = (f32x4){bflo(w.z), bfhi(w.z), bflo(w.w), bfhi(w.w)}; } }
        *(f32x4*)o = v0; *(f32x4*)(o + 4) = v1;
    }
}

__device__ __forceinline__ void phase_ln(const float* U, const float* g, const float* b, float* outf, bf16* outb, int gw, int NGW, int lane) {
    for (int row = gw; row < MT; row += NGW) {
        const float* ur = U + (size_t)row * DM + 4 * lane;
        f32x4 v[8]; float s = 0.f;
#pragma unroll
        for (int j = 0; j < 8; ++j) { v[j] = *(const f32x4*)(ur + 256 * j); s += (v[j][0] + v[j][1]) + (v[j][2] + v[j][3]); }
        const float mean = wave_sum(s) * (1.f / DM); float q = 0.f;
#pragma unroll
        for (int j = 0; j < 8; ++j) { v[j] = v[j] - mean; q += (v[j][0] * v[j][0] + v[j][1] * v[j][1]) + (v[j][2] * v[j][2] + v[j][3] * v[j][3]); }
        const float rstd = rsqrtf(wave_sum(q) * (1.f / DM) + LN_EPS);
#pragma unroll
        for (int j = 0; j < 8; ++j) {
            const f32x4 gg = *(const f32x4*)(g + 4 * lane + 256 * j), bb = *(const f32x4*)(b + 4 * lane + 256 * j);
            const f32x4 o = v[j] * rstd * gg + bb;
            *(f32x4*)(outf + (size_t)row * DM + 4 * lane + 256 * j) = o;
            if (outb) *(v2u*)(outb + (size_t)row * DM + 4 * lane + 256 * j) = pk4(o);
        }
    }
}

__device__ __forceinline__ void ffn_taps(const float* fw, const float* fb, int col, float (&w)[3][8], float (&bias)[8]) {
#pragma unroll
    for (int j = 0; j < 3; ++j) { const f32x4 a0 = *(const f32x4*)(fw + (size_t)j * 2 * DFF + col), a1 = *(const f32x4*)(fw + (size_t)j * 2 * DFF + col + 4);
        w[j][0] = a0[0]; w[j][1] = a0[1]; w[j][2] = a0[2]; w[j][3] = a0[3]; w[j][4] = a1[0]; w[j][5] = a1[1]; w[j][6] = a1[2]; w[j][7] = a1[3]; }
    const f32x4 b0 = *(const f32x4*)(fb + col), b1 = *(const f32x4*)(fb + col + 4);
    bias[0] = b0[0]; bias[1] = b0[1]; bias[2] = b0[2]; bias[3] = b0[3]; bias[4] = b1[0]; bias[5] = b1[1]; bias[6] = b1[2]; bias[7] = b1[3];
}
__device__ __forceinline__ void ld8bf(const bf16* p, float (&v)[8]) { const v4u w = *(const v4u*)p; v[0] = bflo(w.x); v[1] = bfhi(w.x); v[2] = bflo(w.y); v[3] = bfhi(w.y); v[4] = bflo(w.z); v[5] = bfhi(w.z); v[6] = bflo(w.w); v[7] = bfhi(w.w); }
__device__ __forceinline__ void ld8f(const float* p, float (&v)[8]) { const f32x4 a0 = *(const f32x4*)p, a1 = *(const f32x4*)(p + 4); v[0] = a0[0]; v[1] = a0[1]; v[2] = a0[2]; v[3] = a0[3]; v[4] = a1[0]; v[5] = a1[1]; v[6] = a1[2]; v[7] = a1[3]; }
__device__ __forceinline__ void st8f(float* p, const float (&v)[8]) { *(f32x4*)p = (f32x4){v[0], v[1], v[2], v[3]}; *(f32x4*)(p + 4) = (f32x4){v[4], v[5], v[6], v[7]}; }
__device__ __forceinline__ void phase_e2(const Args& a, int l, int vcu, int G, int tid) {
    const bf16* HPRE = (const bf16*)(a.ws + WS_HPRE); bf16* HACT = (bf16*)(a.ws + WS_HACT);
    const float* fw = a.in[21] + (size_t)l * 3 * 2 * DFF; const float* fb = a.in[22] + (size_t)l * 2 * DFF;
    const float* stf = a.in[5] + (size_t)l * NDEC * 2 * 2 * DFF;
    float* ofp = a.out + O_FFN_P + (size_t)l * NB * 2 * 2 * DFF; float* ofs = a.out + O_FFN_S + (size_t)l * NDEC * 2 * 2 * DFF;
    for (int ch = tid; ch < DFF / 8; ch += 512) {
        const int c8 = ch * 8;
        float wg[3][8], bg_[8], wv[3][8], bv[8];
        ffn_taps(fw, fb, c8, wg, bg_); ffn_taps(fw, fb, DFF + c8, wv, bv);
        for (int rb = vcu; rb < MP / 32; rb += G) {
        const int r0 = 32 * rb, t0 = r0 & (SEQ - 1);
        float g2[8], g1[8], v2[8], v1[8];
#pragma unroll
        for (int e = 0; e < 8; ++e) { g2[e] = 0.f; g1[e] = 0.f; v2[e] = 0.f; v1[e] = 0.f; }
        if (t0 >= 2) { ld8bf(HPRE + (size_t)(r0 - 2) * 2 * DFF + c8, g2); ld8bf(HPRE + (size_t)(r0 - 2) * 2 * DFF + DFF + c8, v2);
                       ld8bf(HPRE + (size_t)(r0 - 1) * 2 * DFF + c8, g1); ld8bf(HPRE + (size_t)(r0 - 1) * 2 * DFF + DFF + c8, v1); }
        for (int i = 0; i < 32; ++i) {
            const int r = r0 + i, t = t0 + i;
            float g0[8], v0[8]; ld8bf(HPRE + (size_t)r * 2 * DFF + c8, g0); ld8bf(HPRE + (size_t)r * 2 * DFF + DFF + c8, v0);
            float o[8];
#pragma unroll
            for (int e = 0; e < 8; ++e) { const float hg = bg_[e] + wg[0][e] * g2[e] + wg[1][e] * g1[e] + wg[2][e] * g0[e], hv = bv[e] + wv[0][e] * v2[e] + wv[1][e] * v1[e] + wv[2][e] * v0[e]; o[e] = siluf(hg) * hv; }
            v4u w; w.x = pk2(o[0], o[1]); w.y = pk2(o[2], o[3]); w.z = pk2(o[4], o[5]); w.w = pk2(o[6], o[7]);
            *(v4u*)(HACT + (size_t)r * DFF + c8) = w;
            if (t >= SEQ - 2) { float* o2 = ofp + ((size_t)(r >> 11) * 2 + (t - (SEQ - 2))) * 2 * DFF; st8f(o2 + c8, g0); st8f(o2 + DFF + c8, v0); }
#pragma unroll
            for (int e = 0; e < 8; ++e) { g2[e] = g1[e]; g1[e] = g0[e]; v2[e] = v1[e]; v1[e] = v0[e]; }
        }
        }
        for (int s = vcu; s < NDEC; s += G) {
            const int r = MP + s;
            float g2[8], g1[8], v2[8], v1[8];
            const float* sp = stf + (size_t)s * 2 * 2 * DFF;
            ld8f(sp + c8, g2); ld8f(sp + DFF + c8, v2); ld8f(sp + 2 * DFF + c8, g1); ld8f(sp + 2 * DFF + DFF + c8, v1);
            float g0[8], v0[8]; ld8bf(HPRE + (size_t)r * 2 * DFF + c8, g0); ld8bf(HPRE + (size_t)r * 2 * DFF + DFF + c8, v0);
            float o[8];
#pragma unroll
            for (int e = 0; e < 8; ++e) { const float hg = bg_[e] + wg[0][e] * g2[e] + wg[1][e] * g1[e] + wg[2][e] * g0[e], hv = bv[e] + wv[0][e] * v2[e] + wv[1][e] * v1[e] + wv[2][e] * v0[e]; o[e] = siluf(hg) * hv; }
            v4u w; w.x = pk2(o[0], o[1]); w.y = pk2(o[2], o[3]); w.z = pk2(o[4], o[5]); w.w = pk2(o[6], o[7]);
            *(v4u*)(HACT + (size_t)r * DFF + c8) = w;
            float* o2 = ofs + (size_t)s * 2 * 2 * DFF; st8f(o2 + c8, g1); st8f(o2 + DFF + c8, v1); st8f(o2 + 2 * DFF + c8, g0); st8f(o2 + 2 * DFF + DFF + c8, v0);
        }
    }
}

constexpr int PH_PER_LAYER = 11, N_PHASES = 1 + DEPTH * PH_PER_LAYER;
#ifndef MK_PER_PHASE
#define MK_PER_PHASE 0
#endif

__global__ void __launch_bounds__(NWAVES * 64, 2) mega_fwd(Args args) {
    extern __shared__ __attribute__((aligned(16))) unsigned char lds_raw[];
    LAS unsigned char* lds = (LAS unsigned char*)lds_raw;
    volatile LAS unsigned* MISC = (volatile LAS unsigned*)(lds + MISC_OFF);
    const int tid = threadIdx.x, lane = tid & 63, wave = __builtin_amdgcn_readfirstlane(tid >> 6);
    const int G = gridDim.x, bx = blockIdx.x, vcu = (G % 8 == 0) ? (bx % 8) * (G / 8) + bx / 8 : bx;
    const int gw = vcu * NWAVES + wave, NGW = G * NWAVES, gt = vcu * 512 + tid, NGT = G * 512;
    for (int u = tid; u < (LDS_BYTES - MISC_OFF) / 4; u += NWAVES * 64) ((LAS unsigned*)(lds + MISC_OFF))[u] = 0u;
    __syncthreads();
    unsigned* ctl = (unsigned*)(args.ws + WS_CTL);
    XcdBarrier bar; bar.bar = ctl + CW_BAR; bar.x = 0; bar.st = nullptr;
    if (!MK_PER_PHASE) bar = xcd_barrier_post(ctl + CW_BAR, MISC + 8);
    const int lo = args.ph_lo, hi = args.ph_hi;
#define IN(k) (lo <= (k) && (k) < hi)
#define SEAM(k) do { if (!MK_PER_PHASE && IN((k) + 1)) xcd_barrier(bar); } while (0)

#define PH_IDS int tidp = tid; asm volatile("" : "+v"(tidp)); int vcup = vcu; asm volatile("" : "+s"(vcup)); const int lanep = tidp & 63, wavep = __builtin_amdgcn_readfirstlane(tidp >> 6); \
    const int gwp = vcup * NWAVES + wavep, gtp = vcup * 512 + tidp; (void)lanep; (void)wavep; (void)gwp; (void)gtp;
    if (IN(0)) { const Args& a = fresh_args(); PH_IDS p0_prologue(a, lds, gwp, NGW, gtp, NGT, wavep, lanep); SEAM(0); }

#define WSP(T, off) ((T*)(a.ws + (off)))
#define WLP(off) ((const bf16*)(a.ws + WS_W + (size_t)l * WL_SIZE + (off)))
    for (int l = 0; l < DEPTH; ++l) {
        const int P = 1 + l * PH_PER_LAYER;
        if (IN(P + 0)) {
            const Args& a = fresh_args(); PH_IDS
            bf16* XB = WSP(bf16, WS_XB); bf16* PROJ = WSP(bf16, WS_PROJ); const bf16* WIN = WLP(WL_WIN);
            { pg8::Gemm g{XB, WIN, MP, NPROJ, DM, DM, DM, 1 << 30, 0}; pg8::StaticOrder S; S.init(MP, NPROJ, G, bx);
              pg8::EpiBf16<0> E{PROJ, NPROJ, nullptr, 0, 0, 1.f};
              pg8::gemm_phase<pg8::EpiBf16<0>, pg8::StaticOrder, true, true>(lds, g, S, E, tidp); }
            __syncthreads();
            const FProj f{PROJ, WSP(float, WS_DT)};
            for (int u = vcup; u < 257 + 64; u += G) {
                if (u < 257) skinny_unit<4>(lds, XB + (size_t)MP * DM, DM, WIN + (size_t)u * 64 * DM, DM, DM, MP, 64 * u, f, wavep, lanep);
                else skinny_unit<4>(lds, XB + (size_t)(u - 257) * 128 * DM, DM, WIN + (size_t)NPROJ * DM, DM, DM, (u - 257) * 128, NPROJ, f, wavep, lanep);
            }
            SEAM(P + 0);
        }
        if (IN(P + 1)) {
            const Args& a = fresh_args(); PH_IDS
            for (int u = vcup; u < NB * NH; u += G) ssd_prompt_unit(a, lds, l, u / NH, u % NH, tidp, wavep, lanep);
            for (int q = gwp; q < NDEC * NH; q += NGW) ssd_decode_pair(a, l, q / NH, q % NH, lanep);
            SEAM(P + 1);
        }
        if (IN(P + 2)) { const Args& a = fresh_args(); PH_IDS phase_b2(a, l, gtp, NGT); SEAM(P + 2); }
        if (IN(P + 3)) {
            const Args& a = fresh_args(); PH_IDS
            const bf16* POOLED = WSP(bf16, WS_POOLED); const bf16* WPOOL = WLP(WL_WPOOL);
            const FYb f{a.in[16] + (size_t)l * DP, WSP(bf16, WS_YB)};
            { pg8::Gemm g{POOLED, WPOOL, MP, DM, 512, DP, 512, 2, 512}; pg8::StaticOrder S; S.init(MP, DM, G, bx);
              Epi4<FYb> E{f}; pg8::gemm_phase<Epi4<FYb>, pg8::StaticOrder, true, true>(lds, g, S, E, tidp); }
            __syncthreads();
            for (int u = vcup; u < 128; u += G) skinny_unit<1>(lds, POOLED + (size_t)MP * DP + (u / 32) * 512, DP, WPOOL + (size_t)u * 16 * 512, 512, 512, MP, 16 * u, f, wavep, lanep);
            SEAM(P + 3);
        }
        if (IN(P + 4)) {
            const Args& a = fresh_args(); PH_IDS
            const bf16* YN = WSP(bf16, WS_YN); const bf16* WBR = WLP(WL_WBR);
            const FMix f{WSP(bf16, WS_PROJ), a.in[7] + (size_t)l * 2 * DM, WSP(bf16, WS_YB), WSP(bf16, WS_MIX)};
            { pg8::Gemm g{YN, WBR, MP, DM, DI, DI, DI, 1 << 30, 0}; pg8::StaticOrder S; S.init(MP, DM, G, bx);
              Epi4<FMix> E{f}; pg8::gemm_phase<Epi4<FMix>, pg8::StaticOrder, true, true>(lds, g, S, E, tidp); }
            __syncthreads();
            for (int u = vcup; u < 128; u += G) skinny_unit<1>(lds, YN + (size_t)MP * DI, DI, WBR + (size_t)u * 16 * DI, DI, DI, MP, 16 * u, f, wavep, lanep);
            SEAM(P + 4);
        }
        if (IN(P + 5)) {
            const Args& a = fresh_args(); PH_IDS
            const bf16* MIX = WSP(bf16, WS_MIX); const bf16* WOUT = WLP(WL_WOUT);
            RowSrc xsrc; if (l == 0) { xsrc.p = a.in[0]; xsrc.s = a.in[1]; } else { xsrc.p = WSP(float, WS_XF); xsrc.s = WSP(float, WS_XF) + (size_t)MP * DM; }
            const FRes f{xsrc, WSP(float, WS_U)};
            { pg8::Gemm g{MIX, WOUT, MP, DM, DM, DM, DM, 1 << 30, 0}; pg8::StaticOrder S; S.init(MP, DM, G, bx);
              Epi4<FRes> E{f}; pg8::gemm_phase<Epi4<FRes>, pg8::StaticOrder, true, true>(lds, g, S, E, tidp); }
            __syncthreads();
            for (int u = vcup; u < 128; u += G) skinny_unit<1>(lds, MIX + (size_t)MP * DM, DM, WOUT + (size_t)u * 16 * DM, DM, DM, MP, 16 * u, f, wavep, lanep);
            SEAM(P + 5);
        }
        if (IN(P + 6)) { const Args& a = fresh_args(); PH_IDS phase_ln(WSP(float, WS_U), a.in[18] + (size_t)l * DM, a.in[19] + (size_t)l * DM, WSP(float, WS_X1F), WSP(bf16, WS_X1B), gwp, NGW, lanep); SEAM(P + 6); }
        if (IN(P + 7)) {
            const Args& a = fresh_args(); PH_IDS
            const bf16* X1B = WSP(bf16, WS_X1B); const bf16* WUP = WLP(WL_WUP); bf16* HPRE = WSP(bf16, WS_HPRE);
            { pg8::Gemm g{X1B, WUP, MP, 2 * DFF, DM, DM, DM, 1 << 30, 0}; pg8::StaticOrder S; S.init(MP, 2 * DFF, G, bx);
              pg8::EpiBf16<0> E{HPRE, 2 * DFF, nullptr, 0, 0, 1.f};
              pg8::gemm_phase<pg8::EpiBf16<0>, pg8::StaticOrder, true, true>(lds, g, S, E, tidp); }
            __syncthreads();
            const FBf f{HPRE, 2 * DFF};
            for (int u = vcup; u < 172; u += G) skinny_unit<4>(lds, X1B + (size_t)MP * DM, DM, WUP + (size_t)u * 64 * DM, DM, DM, MP, 64 * u, f, wavep, lanep);
            SEAM(P + 7);
        }
        if (IN(P + 8)) { const Args& a = fresh_args(); PH_IDS phase_e2(a, l, vcup, G, tidp); SEAM(P + 8); }
        if (IN(P + 9)) {
            const Args& a = fresh_args(); PH_IDS
            const bf16* HACT = WSP(bf16, WS_HACT); const bf16* WDOWN = WLP(WL_WDOWN);
            RowSrc x1; x1.p = WSP(float, WS_X1F); x1.s = WSP(float, WS_X1F) + (size_t)MP * DM;
            const FRes f{x1, WSP(float, WS_U)};
            { pg8::Gemm g{HACT, WDOWN, MP, DM, DFF, DFF, DFF, 1 << 30, 0}; pg8::StaticOrder S; S.init(MP, DM, G, bx);
              Epi4<FRes> E{f}; pg8::gemm_phase<Epi4<FRes>, pg8::StaticOrder, true, true>(lds, g, S, E, tidp); }
            __syncthreads();
            for (int u = vcup; u < 128; u += G) skinny_unit<1>(lds, HACT + (size_t)MP * DFF, DFF, WDOWN + (size_t)u * 16 * DFF, DFF, DFF, MP, 16 * u, f, wavep, lanep);
            SEAM(P + 9);
        }
        if (IN(P + 10)) {
            const Args& a = fresh_args(); PH_IDS
            if (l == DEPTH - 1) phase_ln(WSP(float, WS_U), a.in[24] + (size_t)l * DM, a.in[25] + (size_t)l * DM, a.out + O_YP, nullptr, gwp, NGW, lanep);
            else phase_ln(WSP(float, WS_U), a.in[24] + (size_t)l * DM, a.in[25] + (size_t)l * DM, WSP(float, WS_XF), WSP(bf16, WS_XB), gwp, NGW, lanep);
            if (l != DEPTH - 1) SEAM(P + 10);
        }
    }
#undef WSP
#undef WLP
#undef IN
#undef SEAM
}

extern "C" void kernel_launch(void* const* d_in, const int* in_sizes, int n_in, void* d_out, int out_size, void* d_ws, size_t ws_size, hipStream_t stream) {
    static int grid = 0;
    if (grid == 0) {
        if (n_in != 26 || (size_t)out_size != O_END || ws_size < WS_END) { fprintf(stderr, "kernel_launch: unexpected n_in %d / out_size %d / ws %zu (want 26 / %zu / >= %zu)\n", n_in, out_size, ws_size, (size_t)O_END, (size_t)WS_END); grid = -1; return; }
        int dev = 0, cus = 0, per_cu = 0;
        if (hipGetDevice(&dev) != hipSuccess || hipDeviceGetAttribute(&cus, hipDeviceAttributeMultiprocessorCount, dev) != hipSuccess) { grid = -1; return; }
        if (hipFuncSetAttribute((const void*)mega_fwd, hipFuncAttributeMaxDynamicSharedMemorySize, LDS_BYTES) != hipSuccess) { fprintf(stderr, "kernel_launch: hipFuncSetAttribute failed\n"); grid = -1; return; }
        if (hipOccupancyMaxActiveBlocksPerMultiprocessor(&per_cu, (const void*)mega_fwd, NWAVES * 64, LDS_BYTES) != hipSuccess || per_cu < 1) { fprintf(stderr, "kernel_launch: occupancy query says %d blocks per CU\n", per_cu); (void)hipGetLastError(); grid = -1; return; }
        grid = cus;
    }
    if (grid < 0) return;
    if (hipMemsetAsync((char*)d_ws + WS_CTL, 0, CTL_ZERO_BYTES, stream) != hipSuccess) return;
    Args a{};
    for (int i = 0; i < 26; ++i) a.in[i] = (const float*)d_in[i];
    a.out = (float*)d_out; a.ws = (unsigned char*)d_ws;
#if MK_PER_PHASE
    for (int p = 0; p < N_PHASES; ++p) { a.ph_lo = p; a.ph_hi = p + 1; hipLaunchKernelGGL(mega_fwd, dim3(grid), dim3(NWAVES * 64), LDS_BYTES, stream, a); }
#else
    a.ph_lo = 0; a.ph_hi = N_PHASES;
    hipLaunchKernelGGL(mega_fwd, dim3(grid), dim3(NWAVES * 64), LDS_BYTES, stream, a);
#endif
}
```

```cpp
#include <hip/hip_runtime.h>
#include <cstdio>
#include <cstdint>
namespace pg8 {
#define PG8_LAS __attribute__((address_space(3)))
typedef unsigned short bf16_t;
typedef short bf16x8 __attribute__((ext_vector_type(8)));
typedef float f32x4 __attribute__((ext_vector_type(4)));
typedef unsigned u32x4 __attribute__((ext_vector_type(4)));
constexpr int BM = 256, BK = 64, HALF = 128, HTB = HALF * BK * 2  , STAGE_BYTES = 8 * HTB, NXCD = 8, WGM = 8;

__host__ __device__ __forceinline__ int lds_byte(int r, int c) { const int st = (r >> 4) * 2 + (c >> 5), rr = r & 15, cc = c & 31, ob = rr * 64 + cc * 2; return st * 1024 + (ob ^ (((ob >> 9) & 1) << 5)); }
__host__ __device__ __forceinline__ void stage_rc(int b, int& R, int& C) { const int st = b / 1024, sb = b % 1024, swz = sb ^ (((sb >> 9) & 1) << 5); R = (st >> 1) * 16 + swz / 64; C = (st & 1) * 32 + (swz % 64) / 2; }
__host__ __device__ __forceinline__ int perm32(int rho) { const int n = rho >> 4, i = rho & 15; return 8 * (i >> 2) + 4 * n + (i & 3); }

struct Unit { int pm, pn; };
struct Gemm { const bf16_t* A; const bf16_t* Bt; int M, N, K, lda, ldb, agdiv, agstride; };

struct StaticOrder {
    int nM, nN, nwg, G, c;
    __host__ __device__ void init(int M, int N, int G_, int c_) { nM = M / BM; nN = N / BM; nwg = nM * nN; G = G_; c = c_; }
    __host__ __device__ bool next(int i, Unit& u) const {
        const long L = (long)i * G + c; if (L >= nwg) return false;
        int wgid = (int)L; { const int q = nwg / NXCD, r = nwg % NXCD, xcd = wgid % NXCD, off = wgid / NXCD; wgid = (xcd < r ? xcd * (q + 1) : r * (q + 1) + (xcd - r) * q) + off; }
        const int nig = WGM * nN, gid = wgid / nig, fm = gid * WGM, gsz = (nM - fm) < WGM ? (nM - fm) : WGM;
        u.pm = fm + ((wgid % nig) % gsz); u.pn = (wgid % nig) / gsz; return true;
    }
    __device__ __forceinline__ void a_ready(const Unit&) const {}
    __device__ __forceinline__ void done(const Unit&) const {}
};

__device__ __forceinline__ unsigned cvt_pk_bf16(float lo, float hi) { unsigned r; asm volatile("v_cvt_pk_bf16_f32 %0, %1, %2" : "=v"(r) : "v"(lo), "v"(hi)); return r; }
typedef float f32x2 __attribute__((ext_vector_type(2)));
__device__ __forceinline__ f32x2 gelu_pk(f32x2 v) {
    const f32x2 av = __builtin_elementwise_abs(v), d = av * 0.2316418882f + 1.0f;
    f32x2 t; t.x = __builtin_amdgcn_rcpf(d.x); t.y = __builtin_amdgcn_rcpf(d.y);
    f32x2 q = t * 0.5307027145f + (-0.7265760135f); q = q * t + 0.7107068705f; q = q * t + (-0.142248368f); q = q * t + 0.127414796f; q = q * t;
    const f32x2 s = (v * v) * (-0.72134752044f);
    f32x2 e; e.x = __builtin_amdgcn_exp2f(s.x); e.y = __builtin_amdgcn_exp2f(s.y);
    const f32x2 m = v * (q * e), r = v - m;
    f32x2 o; o.x = v.x < 0.f ? m.x : r.x; o.y = v.y < 0.f ? m.y : r.y; return o;
}

template <int ACT  > struct EpiBf16 {
    static constexpr bool PERM = true, AFTER_DRAIN = false; static_assert(ACT == 0 || ACT == 1, "EpiBf16: ACT is 0 (none) or 1 (gelu_pk)");
    bf16_t* O; int ldc; const float* bias; int split_cols; size_t split_stride; float scale0;
    __device__ __forceinline__ void operator()(const f32x4 (&acc)[2][2][4][2], const Unit& u, int wr, int wc, int fr, int fq) const {
        const int row0 = u.pm * BM + wr * 64 + fr; int colt = u.pn * BM; bf16_t* base = O;
        float sc = 1.f; if (split_cols) { const int t = colt / split_cols; base += (size_t)t * split_stride; colt -= t * split_cols; if (t == 0) sc = scale0; }
        const int col0 = colt + wc * 32 + 8 * fq, bcol0 = u.pn * BM + wc * 32 + 8 * fq;
        f32x4 bv[2][2];
#pragma unroll
        for (int bj = 0; bj < 2; ++bj)
#pragma unroll
            for (int n = 0; n < 2; ++n) bv[bj][n] = bias ? *(const f32x4*)(bias + bcol0 + bj * HALF + 4 * n) : (f32x4){0.f, 0.f, 0.f, 0.f};
#pragma unroll
        for (int ai = 0; ai < 2; ++ai)
#pragma unroll
            for (int m = 0; m < 4; ++m) { bf16_t* rowp = base + (size_t)(row0 + ai * HALF + m * 16) * ldc + col0;
#pragma unroll
                for (int bj = 0; bj < 2; ++bj) { f32x4 v0 = acc[ai][bj][m][0] + bv[bj][0], v1 = acc[ai][bj][m][1] + bv[bj][1];
                    if (ACT == 1) { f32x2 a = gelu_pk((f32x2){v0[0], v0[1]}), b = gelu_pk((f32x2){v0[2], v0[3]}), c = gelu_pk((f32x2){v1[0], v1[1]}), d = gelu_pk((f32x2){v1[2], v1[3]});
                        v0 = (f32x4){a.x, a.y, b.x, b.y}; v1 = (f32x4){c.x, c.y, d.x, d.y}; }
                    v0 = v0 * sc; v1 = v1 * sc; u32x4 w; w.x = cvt_pk_bf16(v0[0], v0[1]); w.y = cvt_pk_bf16(v0[2], v0[3]); w.z = cvt_pk_bf16(v1[0], v1[1]); w.w = cvt_pk_bf16(v1[2], v1[3]);
                    *(u32x4*)(rowp + bj * HALF) = w; } }
    }
};

template <class Epi, class Sched, bool ALIGN_EPI = false, bool SP2 = false>
__device__ __forceinline__ void gemm_phase(PG8_LAS unsigned char* lds, const Gemm g, const Sched& S, const Epi& E, const int tid) {
    const int wid = __builtin_amdgcn_readfirstlane(tid >> 6), lane = tid & 63, wr = wid >> 2, wc = wid & 3, fr = lane & 15, fq = lane >> 4;
    const int K = g.K, nt = K / BK;
    unsigned voffA[2], voffB[2];
#pragma unroll
    for (int i = 0; i < 2; ++i) { int R, C; stage_rc(tid * 16 + i * 8192, R, C); const int Rb = Epi::PERM ? ((R & ~31) + perm32(R & 31)) : R;
        voffA[i] = (unsigned)(R * g.lda + C) * 2u; voffB[i] = (unsigned)(Rb * g.ldb + C) * 2u; }
    const size_t kstep = (size_t)(BK * 2);
    const size_t hstepA = (size_t)HALF * g.lda * 2, hstepB = (size_t)HALF * g.ldb * 2;
    const size_t tstepA = 2 * hstepA, tstepB = 2 * hstepB;
    const unsigned ldsw = (unsigned)wid * 1024u;
    const int aoff = lds_byte(wr * 64 + fr, fq * 8), boff = lds_byte(wc * 32 + fr, fq * 8);
#define PG8_SA(b, h) (((b) * 2 + (h)) * HTB)
#define PG8_SB(b, h) ((4 + (b) * 2 + (h)) * HTB)
#define PG8_STAGE(bufoff, gbase, voff) do { _Pragma("unroll") for (int _i = 0; _i < 2; ++_i) \
        __builtin_amdgcn_global_load_lds((const unsigned*)((const char*)(gbase) + (voff)[_i]), (PG8_LAS unsigned*)(lds + (bufoff) + ldsw + _i * 8192), 16, 0, 0); } while (0)
#define PG8_LDA(dst, b, h) do { _Pragma("unroll") for (int m = 0; m < 4; ++m) _Pragma("unroll") for (int k = 0; k < 2; ++k) dst[m][k] = *(const PG8_LAS bf16x8*)(lds + PG8_SA(b, h) + aoff + m * 2048 + k * 1024); } while (0)
#define PG8_LDB(dst, b, h) do { _Pragma("unroll") for (int n = 0; n < 2; ++n) _Pragma("unroll") for (int k = 0; k < 2; ++k) dst[n][k] = *(const PG8_LAS bf16x8*)(lds + PG8_SB(b, h) + boff + n * 2048 + k * 1024); } while (0)
#define PG8_MMA(ai, bj, At, Bt) do { __builtin_amdgcn_s_setprio(1); _Pragma("unroll") for (int m = 0; m < 4; ++m) _Pragma("unroll") for (int n = 0; n < 2; ++n) _Pragma("unroll") for (int k = 0; k < 2; ++k) \
        acc[ai][bj][m][n] = __builtin_amdgcn_mfma_f32_16x16x32_bf16(Bt[n][k], At[m][k], acc[ai][bj][m][n], 0, 0, 0); __builtin_amdgcn_s_setprio(0); } while (0)
#define PG8_WAIT_V(n) asm volatile("s_waitcnt vmcnt(" #n ")" ::: "memory")
#define PG8_WAIT_L(n) asm volatile("s_waitcnt lgkmcnt(" #n ")" ::: "memory")
#define PG8_BAR __builtin_amdgcn_s_barrier()
#define PG8_SCHED __builtin_amdgcn_sched_barrier(0)
    Unit cur, nxt; int ui = 0;
    if (!S.next(0, cur)) return;
    f32x4 acc[2][2][4][2];
#pragma unroll
    for (int a = 0; a < 2; ++a)
#pragma unroll
        for (int b = 0; b < 2; ++b)
#pragma unroll
            for (int m = 0; m < 4; ++m)
#pragma unroll
                for (int n = 0; n < 2; ++n) acc[a][b][m][n] = (f32x4){0.f, 0.f, 0.f, 0.f};
    bf16x8 At[4][2], B0[2][2], B1[2][2];
    const char* cA = (const char*)g.A + (size_t)cur.pm * tstepA + (size_t)((cur.pn / g.agdiv) * g.agstride) * 2; const char* cB = (const char*)g.Bt + (size_t)cur.pn * tstepB;
    S.a_ready(cur);
    if constexpr (SP2) {
        PG8_STAGE(PG8_SB(0, 0), cB, voffB); PG8_STAGE(PG8_SB(0, 1), cB + hstepB, voffB); PG8_STAGE(PG8_SA(0, 0), cA, voffA); PG8_STAGE(PG8_SA(0, 1), cA + hstepA, voffA);
        if (wr == 1) PG8_BAR;
        PG8_WAIT_V(2); PG8_BAR;
        PG8_STAGE(PG8_SB(1, 0), cB + kstep, voffB); PG8_STAGE(PG8_SA(1, 0), cA + kstep, voffA); PG8_STAGE(PG8_SB(1, 1), cB + hstepB + kstep, voffB);
        PG8_WAIT_V(6); PG8_BAR;
    } else {
        PG8_STAGE(PG8_SB(0, 0), cB, voffB); PG8_STAGE(PG8_SA(0, 0), cA, voffA); PG8_STAGE(PG8_SB(0, 1), cB + hstepB, voffB); PG8_STAGE(PG8_SA(0, 1), cA + hstepA, voffA);
        if (wr == 1) PG8_BAR;
        PG8_WAIT_V(4); PG8_BAR;
        PG8_STAGE(PG8_SB(1, 0), cB + kstep, voffB); PG8_STAGE(PG8_SA(1, 0), cA + kstep, voffA); PG8_STAGE(PG8_SB(1, 1), cB + hstepB + kstep, voffB);
        PG8_WAIT_V(6); PG8_BAR;
    }
    for (;;) {
        const bool has_next = S.next(ui + 1, nxt);
        const char* nA = has_next ? (const char*)g.A + (size_t)nxt.pm * tstepA + (size_t)((nxt.pn / g.agdiv) * g.agstride) * 2 : cA; const char* nB = has_next ? (const char*)g.Bt + (size_t)nxt.pn * tstepB : cB;
        for (int t = 0; t < nt; t += 2) {
            const bool last = (t == nt - 2);
            const char* a1 = cA + (size_t)(t + 1) * kstep;
            const char* a2 = last ? nA : cA + (size_t)(t + 2) * kstep; const char* b2 = last ? nB : cB + (size_t)(t + 2) * kstep;
            const char* a3 = a2 + kstep; const char* b3 = b2 + kstep;
            if (last && has_next) S.a_ready(nxt);
            if constexpr (SP2) {
            PG8_LDB(B0, 0, 0); PG8_LDB(B1, 0, 1); PG8_SCHED; PG8_LDA(At, 0, 0); PG8_STAGE(PG8_SA(1, 1), a1 + hstepA, voffA);
            PG8_WAIT_V(8); PG8_WAIT_L(0); PG8_BAR; PG8_MMA(0, 0, At, B0); PG8_MMA(0, 1, At, B1); PG8_BAR; PG8_SCHED;
            PG8_LDA(At, 0, 1); PG8_STAGE(PG8_SB(0, 0), b2, voffB); PG8_STAGE(PG8_SB(0, 1), b2 + hstepB, voffB); PG8_STAGE(PG8_SA(0, 0), a2, voffA);
            PG8_WAIT_V(8); PG8_WAIT_L(0); PG8_BAR; PG8_MMA(1, 0, At, B0); PG8_MMA(1, 1, At, B1); PG8_BAR; PG8_SCHED;
            PG8_LDB(B0, 1, 0); PG8_LDB(B1, 1, 1); PG8_SCHED; PG8_LDA(At, 1, 0); PG8_STAGE(PG8_SA(0, 1), a2 + hstepA, voffA);
            PG8_WAIT_V(8); PG8_WAIT_L(0); PG8_BAR; PG8_MMA(0, 0, At, B0); PG8_MMA(0, 1, At, B1); PG8_BAR; PG8_SCHED;
            PG8_LDA(At, 1, 1); PG8_STAGE(PG8_SB(1, 0), b3, voffB); PG8_STAGE(PG8_SB(1, 1), b3 + hstepB, voffB); PG8_STAGE(PG8_SA(1, 0), a3, voffA);
            PG8_WAIT_V(8); PG8_WAIT_L(0); PG8_BAR; PG8_MMA(1, 0, At, B0); PG8_MMA(1, 1, At, B1); PG8_BAR; PG8_SCHED;
            } else {
            PG8_LDB(B0, 0, 0); PG8_SCHED; PG8_LDA(At, 0, 0); PG8_STAGE(PG8_SA(1, 1), a1 + hstepA, voffA);
            PG8_WAIT_L(8); PG8_BAR; PG8_WAIT_L(0); PG8_MMA(0, 0, At, B0); PG8_BAR; PG8_SCHED;
            PG8_LDB(B1, 0, 1); PG8_STAGE(PG8_SB(0, 0), b2, voffB);
            PG8_BAR; PG8_WAIT_L(0); PG8_MMA(0, 1, At, B1); PG8_BAR;
            PG8_LDA(At, 0, 1); PG8_STAGE(PG8_SA(0, 0), a2, voffA);
            PG8_BAR; PG8_WAIT_L(0); PG8_MMA(1, 0, At, B0); PG8_BAR; PG8_SCHED;
            PG8_STAGE(PG8_SB(0, 1), b2 + hstepB, voffB);
            PG8_WAIT_V(6); PG8_BAR; PG8_MMA(1, 1, At, B1); PG8_BAR;
            PG8_LDB(B0, 1, 0); PG8_SCHED; PG8_LDA(At, 1, 0); PG8_STAGE(PG8_SA(0, 1), a2 + hstepA, voffA);
            PG8_WAIT_L(8); PG8_BAR; PG8_WAIT_L(0); PG8_MMA(0, 0, At, B0); PG8_BAR; PG8_SCHED;
            PG8_LDB(B1, 1, 1); PG8_STAGE(PG8_SB(1, 0), b3, voffB);
            PG8_BAR; PG8_WAIT_L(0); PG8_MMA(0, 1, At, B1); PG8_BAR;
            PG8_LDA(At, 1, 1); PG8_STAGE(PG8_SA(1, 0), a3, voffA);
            PG8_BAR; PG8_WAIT_L(0); PG8_MMA(1, 0, At, B0); PG8_BAR; PG8_SCHED;
            PG8_STAGE(PG8_SB(1, 1), b3 + hstepB, voffB);
            PG8_WAIT_V(6); PG8_BAR; PG8_MMA(1, 1, At, B1); PG8_BAR;
            }
        }
        if constexpr (ALIGN_EPI) { if (wr == 0) PG8_BAR; }
        if constexpr (!Epi::AFTER_DRAIN) { E(acc, cur, wr, wc, fr, fq); S.done(cur); }
        if (!has_next) break;
#pragma unroll
        for (int a = 0; a < 2; ++a)
#pragma unroll
            for (int b = 0; b < 2; ++b)
#pragma unroll
                for (int m = 0; m < 4; ++m)
#pragma unroll
                    for (int n = 0; n < 2; ++n) acc[a][b][m][n] = (f32x4){0.f, 0.f, 0.f, 0.f};
        cur = nxt; cA = nA; cB = nB; ++ui;
        if constexpr (ALIGN_EPI) { if (wr == 1) PG8_BAR; }
    }
    PG8_WAIT_V(0);
    if constexpr (!ALIGN_EPI) { if (wr == 0) PG8_BAR; }
    PG8_BAR;
    if constexpr (Epi::AFTER_DRAIN) { E.fused(acc, cur, wr, wc, fr, fq, lds, wid, lane); S.done(cur); }
#undef PG8_SA
#undef PG8_SB
#undef PG8_STAGE
#undef PG8_LDA
#undef PG8_LDB
#undef PG8_MMA
#undef PG8_WAIT_V
#undef PG8_WAIT_L
#undef PG8_BAR
#undef PG8_SCHED
}
}
#ifndef REP_MASK
#define REP_MASK 0
#endif
constexpr int DM = 2048, NB = 4, SEQ = 2048, DEPTH = 2, NDEC = 128;
constexpr int MP = NB * SEQ;
constexpr int MT = MP + NDEC;
constexpr int DI = 4096, NH = 64, HD = 64, NG = 8, DS = 128, CD = 6144;
constexpr int DP = 2048, PB = 15, DFF = 5504, DIN = 16448, NPROJ = 16384, LDPJ = NPROJ + 64;
constexpr int OFF_Z = 0, OFF_XBC = 4096, OFF_DT = 10240, OFF_POOL = 10304, OFF_GATE = 12352;
constexpr int PC_Z = 0, PC_XBC = 4096, PC_POOL = 10240, PC_GATE = 12288;
constexpr float ALPHA = 1.4142135623730951f;
constexpr float LN_EPS = 1e-5f, RMS_EPS = 1e-5f;
constexpr int NWAVES = 8;

constexpr size_t O_YP = 0;
constexpr size_t O_YS = O_YP + (size_t)NB * SEQ * DM;
constexpr size_t O_SSM_P = O_YS + (size_t)NDEC * DM;
constexpr size_t O_CONV_P = O_SSM_P + (size_t)DEPTH * NB * NH * HD * DS;
constexpr size_t O_POOL_P = O_CONV_P + (size_t)DEPTH * NB * 3 * CD;
constexpr size_t O_FFN_P = O_POOL_P + (size_t)DEPTH * NB * PB * DP;
constexpr size_t O_SSM_S = O_FFN_P + (size_t)DEPTH * NB * 2 * 2 * DFF;
constexpr size_t O_CONV_S = O_SSM_S + (size_t)DEPTH * NDEC * NH * HD * DS;
constexpr size_t O_POOL_S = O_CONV_S + (size_t)DEPTH * NDEC * 3 * CD;
constexpr size_t O_FFN_S = O_POOL_S + (size_t)DEPTH * NDEC * PB * DP;
constexpr size_t O_END = O_FFN_S + (size_t)DEPTH * NDEC * 2 * 2 * DFF;

constexpr size_t MiB = 1u << 20;
constexpr size_t WS_CTL = 0, CTL_ZERO_BYTES = 1 * MiB;
constexpr size_t WL_WIN = 0, WL_WBR = 65 * MiB, WL_WPOOL = 81 * MiB, WL_WOUT = 83 * MiB, WL_WUP = 91 * MiB, WL_WDOWN = 134 * MiB, WL_SIZE = 156 * MiB;
constexpr size_t WS_W = 1 * MiB;
constexpr size_t WS_XB = WS_W + 2 * WL_SIZE;
constexpr size_t WS_XF = WS_XB + 33 * MiB;
constexpr size_t WS_PROJ = WS_XF + 65 * MiB;
constexpr size_t WS_DT = WS_PROJ + 262 * MiB;
constexpr size_t WS_V = WS_DT + 3 * MiB;
constexpr size_t WS_SSQ = WS_V + 65 * MiB;
constexpr size_t WS_YN = WS_SSQ + 3 * MiB;
constexpr size_t WS_POOLED = WS_YN + 65 * MiB;
constexpr size_t WS_YB = WS_POOLED + 33 * MiB;
constexpr size_t WS_MIX = WS_YB + 33 * MiB;
constexpr size_t WS_U = WS_MIX + 33 * MiB;
constexpr size_t WS_X1F = WS_U + 65 * MiB;
constexpr size_t WS_X1B = WS_X1F + 65 * MiB;
constexpr size_t WS_HPRE = WS_X1B + 33 * MiB;
constexpr size_t WS_HACT = WS_HPRE + 175 * MiB;
constexpr size_t WS_XC = WS_HACT + 88 * MiB;
constexpr size_t WS_DTS = WS_XC + 98 * MiB;
constexpr size_t WS_ACUM = WS_DTS + 3 * MiB;
constexpr size_t WS_WJ = WS_ACUM + 3 * MiB;
constexpr size_t WS_END = WS_WJ + 3 * MiB;
static_assert((size_t)MT * CD * 2 <= 98 * MiB, "act map 3");
static_assert((size_t)DIN * DM * 2 <= 65 * MiB && (size_t)2 * DFF * DM * 2 <= 43 * MiB && (size_t)DM * DFF * 2 <= 22 * MiB, "weight map");
static_assert((size_t)MT * LDPJ * 2 <= 262 * MiB && (size_t)MT * DI * 2 <= 65 * MiB && (size_t)MT * DM * 4 <= 65 * MiB && (size_t)MT * DM * 2 <= 33 * MiB, "act map");
static_assert((size_t)MT * 2 * DFF * 2 <= 175 * MiB && (size_t)MT * DFF * 2 <= 88 * MiB && (size_t)MT * 64 * 4 <= 3 * MiB, "act map 2");
constexpr int CW_BAR = 4096;

constexpr int LDS_BYTES = 156 * 1024;
constexpr int MISC_OFF = 152 * 1024;

#define GAS __attribute__((address_space(1)))
#define LAS __attribute__((address_space(3)))
typedef unsigned short bf16;
typedef unsigned v4u __attribute__((ext_vector_type(4)));
typedef unsigned v2u __attribute__((ext_vector_type(2)));
typedef float f32x4 __attribute__((ext_vector_type(4)));
typedef short bf16x8 __attribute__((ext_vector_type(8)));
typedef short bf16x4 __attribute__((ext_vector_type(4)));
#define LDS_WAIT() asm volatile("s_waitcnt lgkmcnt(0)" ::: "memory")
#define LDS_BARRIER() do { asm volatile("s_waitcnt lgkmcnt(0)" ::: "memory"); __builtin_amdgcn_s_barrier(); asm volatile("" ::: "memory"); } while (0)
#define VM_WAIT() asm volatile("s_waitcnt vmcnt(0)" ::: "memory")
__device__ __forceinline__ unsigned pk2(float lo, float hi) { return pg8::cvt_pk_bf16(lo, hi); }
__device__ __forceinline__ float bflo(unsigned u) { return __builtin_bit_cast(float, u << 16); }
__device__ __forceinline__ float bfhi(unsigned u) { return __builtin_bit_cast(float, u & 0xffff0000u); }
__device__ __forceinline__ float bf1(bf16 u) { return __builtin_bit_cast(float, (unsigned)u << 16); }
__device__ __forceinline__ f32x4 bf4(v2u u) { return (f32x4){bflo(u.x), bfhi(u.x), bflo(u.y), bfhi(u.y)}; }
__device__ __forceinline__ v2u pk4(f32x4 v) { v2u r; r.x = pk2(v[0], v[1]); r.y = pk2(v[2], v[3]); return r; }
__device__ __forceinline__ float siluf(float x) { return x * __builtin_amdgcn_rcpf(1.f + __expf(-x)); }
__device__ __forceinline__ float sigmf(float x) { return __builtin_amdgcn_rcpf(1.f + __expf(-x)); }
__device__ __forceinline__ float softplusf(float x) { return x > 20.f ? x : log1pf(expf(x)); }
__device__ __forceinline__ float wave_sum(float v) {
#pragma unroll
    for (int o = 1; o < 64; o <<= 1) v += __shfl_xor(v, o);
    return v;
}

#define XB_TMO      128
#define XB_XCNT(j)  (256  + 64 * (j))
#define XB_XSUB(j)  (1280 + 64 * (j))
#define XB_XGEN(j)  (2304 + 64 * (j))
#define XB_TOP      3328
#define XB_TOPGEN   3392
#define XCD_BAR_WORDS 3456
#define XB_SPIN_CAP (1u << 18)

__device__ __forceinline__ unsigned xb_ld(unsigned* p)              { return __hip_atomic_load(p, __ATOMIC_RELAXED, __HIP_MEMORY_SCOPE_AGENT); }
__device__ __forceinline__ unsigned xb_add(unsigned* p, unsigned v) { return __hip_atomic_fetch_add(p, v, __ATOMIC_RELAXED, __HIP_MEMORY_SCOPE_AGENT); }
__device__ __forceinline__ unsigned xb_xcc_id() { return (unsigned)__builtin_amdgcn_s_getreg((3 << 11) | 20) & 0xFu; }
#define XB_SPIN(cond, bar) do { unsigned _sp = 0; while (cond) { __builtin_amdgcn_s_sleep(1); \
    if ((++_sp & 255u) == 0u) { if (xb_ld(&(bar)[XB_TMO])) break; if (_sp > XB_SPIN_CAP) { atomicAdd(&(bar)[XB_TMO], 1u); break; } } } } while (0)

struct XcdBarrier {
    unsigned* bar; unsigned x;
    volatile LAS unsigned* st;
};

__device__ __forceinline__ XcdBarrier xcd_barrier_post(unsigned* bar, volatile LAS unsigned* st) {
    XcdBarrier b; b.bar = bar; b.x = xb_xcc_id(); b.st = st;
    if (threadIdx.x == 0) (void)xb_add(&bar[XB_XCNT(b.x)], 1u);
    return b;
}
__device__ __forceinline__ void xcd_barrier_complete(unsigned* bar, unsigned x, unsigned& nloc, unsigned& nx) {
    const unsigned G = gridDim.x * gridDim.y * gridDim.z;
    unsigned sum, cnt, mine, sp = 0u;
    for (;;) {
        sum = 0u; cnt = 0u; mine = 0u;
#pragma unroll
        for (unsigned j = 0; j < 16; ++j) { const unsigned c = xb_ld(&bar[XB_XCNT(j)]); sum += c; cnt += (c > 0u) ? 1u : 0u; mine = (j == x) ? c : mine; }
        if (sum == G) break;
        __builtin_amdgcn_s_sleep(1);
        if ((++sp & 255u) == 0u) { if (xb_ld(&bar[XB_TMO])) break; if (sp > XB_SPIN_CAP) { atomicAdd(&bar[XB_TMO], 1u); break; } }
    }
    nloc = mine > 0u ? mine : 1u; nx = cnt > 0u ? cnt : 1u;
}

__device__ __forceinline__ void xcd_barrier(const XcdBarrier& b) {
    asm volatile("s_waitcnt vmcnt(0)" ::: "memory");
    __syncthreads();
    if (threadIdx.x == 0) {
        unsigned* bar = b.bar;
        __builtin_amdgcn_s_waitcnt(0);
        unsigned nloc = b.st[0], nx = b.st[1];
        if (nloc == 0u) { xcd_barrier_complete(bar, b.x, nloc, nx); b.st[0] = nloc; b.st[1] = nx; }
        const unsigned old = xb_add(&bar[XB_XSUB(b.x)], 1u);
        const unsigned gen = old / nloc;
        if (old + 1u == (gen + 1u) * nloc) {
            __builtin_amdgcn_fence(__ATOMIC_RELEASE, "agent");
            asm volatile("s_waitcnt vmcnt(0)" ::: "memory");
            const unsigned og = xb_add(&bar[XB_TOP], 1u);
            const unsigned tg = og / nx;
            if (og + 1u == (tg + 1u) * nx) xb_add(&bar[XB_TOPGEN], 1u);
            else XB_SPIN(xb_ld(&bar[XB_TOPGEN]) == tg, bar);
            __builtin_amdgcn_fence(__ATOMIC_ACQUIRE, "agent");
            xb_add(&bar[XB_XGEN(b.x)], 1u);
            asm volatile("s_waitcnt vmcnt(0)" ::: "memory");
        } else {
            XB_SPIN(xb_ld(&bar[XB_XGEN(b.x)]) == gen, bar);
            __builtin_amdgcn_fence(__ATOMIC_ACQUIRE, "agent");
            asm volatile("s_waitcnt vmcnt(0)" ::: "memory");
        }
    }
    __syncthreads();
}


struct RowSrc { const float* p; const float* s; __device__ __forceinline__ const float* at(int row) const { return row < MP ? p + (size_t)row * DM : s + (size_t)(row - MP) * DM; } };

template <class F> struct Epi4 {
    static constexpr bool PERM = false, AFTER_DRAIN = false; F f;
    __device__ __forceinline__ void operator()(const pg8::f32x4 (&acc)[2][2][4][2], const pg8::Unit& u, int wr, int wc, int fr, int fq) const {
        const int row0 = u.pm * 256 + wr * 64 + fr, col0 = u.pn * 256 + wc * 32 + 4 * fq;
#pragma unroll
        for (int ai = 0; ai < 2; ++ai)
#pragma unroll
            for (int m = 0; m < 4; ++m)
#pragma unroll
                for (int bj = 0; bj < 2; ++bj)
#pragma unroll
                    for (int n = 0; n < 2; ++n) f(row0 + ai * 128 + m * 16, col0 + bj * 128 + n * 16, acc[ai][bj][m][n]);
    }
};
struct FProj { bf16* PROJ; float* DT;
    __device__ __forceinline__ void operator()(int row, int col, f32x4 v) const {
        if (col < NPROJ) *(v2u*)(PROJ + (size_t)row * LDPJ + col) = pk4(v);
        else *(f32x4*)(DT + (size_t)row * 64 + (col - NPROJ)) = v; } };
struct FYb { const float* scale; bf16* YB;
    __device__ __forceinline__ void operator()(int row, int col, f32x4 v) const {
        const f32x4 s = *(const f32x4*)(scale + col); *(v2u*)(YB + (size_t)row * DM + col) = pk4(v * s); } };
struct FMix { const bf16* PROJ; const float* bg; const bf16* YB; bf16* MIX;
    __device__ __forceinline__ void operator()(int row, int col, f32x4 v) const {
        const f32x4 ga = bf4(*(const v2u*)(PROJ + (size_t)row * LDPJ + PC_GATE + col)) + *(const f32x4*)(bg + col);
        const f32x4 gb = bf4(*(const v2u*)(PROJ + (size_t)row * LDPJ + PC_GATE + DM + col)) + *(const f32x4*)(bg + DM + col);
        const f32x4 yb = bf4(*(const v2u*)(YB + (size_t)row * DM + col));
        f32x4 o;
#pragma unroll
        for (int e = 0; e < 4; ++e) o[e] = sigmf(ga[e]) * v[e] + sigmf(gb[e]) * yb[e];
        *(v2u*)(MIX + (size_t)row * DM + col) = pk4(o); } };
struct FRes { RowSrc x; float* U;
    __device__ __forceinline__ void operator()(int row, int col, f32x4 v) const {
        const f32x4 xr = *(const f32x4*)(x.at(row) + col); *(f32x4*)(U + (size_t)row * DM + col) = xr * ALPHA + v; } };
struct FBf { bf16* O; int ldc;
    __device__ __forceinline__ void operator()(int row, int col, f32x4 v) const { *(v2u*)(O + (size_t)row * ldc + col) = pk4(v); } };

template <int NT, class F>
__device__ __forceinline__ void skinny_unit(LAS unsigned char* lds, const bf16* A, int lda, const bf16* Bt, int ldb, int K, int row0, int col0, const F& f, int wave, int lane) {
    const int l15 = lane & 15, g4 = lane >> 4;
    f32x4 acc[8][NT];
#pragma unroll
    for (int rt = 0; rt < 8; ++rt)
#pragma unroll
        for (int ct = 0; ct < NT; ++ct) acc[rt][ct] = (f32x4){0.f, 0.f, 0.f, 0.f};
    const int nsteps = K / 32;
    const bf16* ap = A + (size_t)l15 * lda + 8 * g4;
    const bf16* bp = Bt + (size_t)l15 * ldb + 8 * g4;
#pragma unroll 2
    for (int s = wave; s < nsteps; s += 8) {
        bf16x8 af[8], bfr[NT];
#pragma unroll
        for (int rt = 0; rt < 8; ++rt) af[rt] = *(const bf16x8*)(ap + (size_t)rt * 16 * lda + 32 * s);
#pragma unroll
        for (int ct = 0; ct < NT; ++ct) bfr[ct] = *(const bf16x8*)(bp + (size_t)ct * 16 * ldb + 32 * s);
#pragma unroll
        for (int rt = 0; rt < 8; ++rt)
#pragma unroll
            for (int ct = 0; ct < NT; ++ct) acc[rt][ct] = __builtin_amdgcn_mfma_f32_16x16x32_bf16(bfr[ct], af[rt], acc[rt][ct], 0, 0, 0);
    }
    constexpr int PITCH = 16 * NT * 4 + 16, SLOT = 128 * PITCH, NBATCH = (NT == 4) ? 2 : 1, WPB = 8 / NBATCH;
    f32x4 r[NT];
#pragma unroll
    for (int ct = 0; ct < NT; ++ct) r[ct] = (f32x4){0.f, 0.f, 0.f, 0.f};
#pragma unroll
    for (int batch = 0; batch < NBATCH; ++batch) {
        if (wave / WPB == batch) {
#pragma unroll
            for (int rt = 0; rt < 8; ++rt)
#pragma unroll
                for (int ct = 0; ct < NT; ++ct) *(LAS f32x4*)(lds + (wave % WPB) * SLOT + (16 * rt + l15) * PITCH + (16 * ct + 4 * g4) * 4) = acc[rt][ct];
        }
        __syncthreads();
#pragma unroll
        for (int slot = 0; slot < WPB; ++slot)
#pragma unroll
            for (int ct = 0; ct < NT; ++ct) r[ct] += *(const LAS f32x4*)(lds + slot * SLOT + (16 * wave + l15) * PITCH + (16 * ct + 4 * g4) * 4);
        __syncthreads();
    }
#pragma unroll
    for (int ct = 0; ct < NT; ++ct) f(row0 + 16 * wave + l15, col0 + 16 * ct + 4 * g4, r[ct]);
}

__device__ __forceinline__ void transpose_item(const float* src, int lds_, int col0, int K, bf16* dst, int drow0, const float* kscale, int ntn, int item, LAS float* scr, int lane) {
    const int kb = item / ntn, nb = item % ntn, k0 = 64 * kb, n0 = 64 * nb;
    f32x4 v[16];
#pragma unroll
    for (int i = 0; i < 16; ++i) { const int kr = 4 * i + (lane >> 4); v[i] = *(const f32x4*)(src + (size_t)(k0 + kr) * lds_ + col0 + n0 + 4 * (lane & 15)); }
    if (kscale) {
#pragma unroll
        for (int i = 0; i < 16; ++i) v[i] = v[i] * kscale[k0 + 4 * i + (lane >> 4)];
    }
#pragma unroll
    for (int i = 0; i < 16; ++i) { LAS float* d = scr + (4 * i + (lane >> 4)) * 65 + 4 * (lane & 15); d[0] = v[i][0]; d[1] = v[i][1]; d[2] = v[i][2]; d[3] = v[i][3]; }
    LDS_WAIT(); asm volatile("" ::: "memory");
    const int c = lane & 7;
#pragma unroll
    for (int j = 0; j < 8; ++j) { const int n = (lane >> 3) + 8 * j; const LAS float* s = scr + (8 * c) * 65 + n;
        v4u o; o.x = pk2(s[0 * 65], s[1 * 65]); o.y = pk2(s[2 * 65], s[3 * 65]); o.z = pk2(s[4 * 65], s[5 * 65]); o.w = pk2(s[6 * 65], s[7 * 65]);
        *(v4u*)(dst + (size_t)(drow0 + n0 + n) * K + k0 + 8 * c) = o; }
    LDS_WAIT(); asm volatile("" ::: "memory");
}

struct Args { const float* in[26]; float* out; unsigned char* ws; int ph_lo, ph_hi; };
__device__ __forceinline__ const Args& fresh_args() {
    auto p = __builtin_amdgcn_kernarg_segment_ptr();
    asm volatile("" : "+s"(p));
    return *(const Args*)p;
}

__device__ __forceinline__ void p0_prologue(const Args& a, LAS unsigned char* lds, int gw, int NGW, int gt, int NGT, int wave, int lane) {
    LAS float* scr = (LAS float*)(lds + wave * 16640);
    constexpr int I_INA = 32 * 160, I_INB = 32 * 1, I_INC = 32 * 96, I_BR = 64 * 32, I_PL = 8 * 8, I_OUT = 32 * 32, I_UP = 32 * 172, I_DN = 86 * 32;
    constexpr int PER_LAYER = I_INA + I_INB + I_INC + I_BR + 4 * I_PL + I_OUT + I_UP + I_DN;
    for (int it = gw; it < 2 * PER_LAYER; it += NGW) {
        const int l = it / PER_LAYER; int r = it % PER_LAYER;
        unsigned char* wl = a.ws + WS_W + (size_t)l * WL_SIZE;
        const float* w_in = a.in[6] + (size_t)l * DM * DIN;
        if (r < I_INA) { transpose_item(w_in, DIN, 0, DM, (bf16*)(wl + WL_WIN), 0, nullptr, 160, r, scr, lane); continue; } r -= I_INA;
        if (r < I_INB) { transpose_item(w_in, DIN, OFF_DT, DM, (bf16*)(wl + WL_WIN), NPROJ, nullptr, 1, r, scr, lane); continue; } r -= I_INB;
        if (r < I_INC) { transpose_item(w_in, DIN, OFF_POOL, DM, (bf16*)(wl + WL_WIN), PC_POOL, nullptr, 96, r, scr, lane); continue; } r -= I_INC;
        if (r < I_BR) { transpose_item(a.in[14] + (size_t)l * DI * DM, DM, 0, DI, (bf16*)(wl + WL_WBR), 0, a.in[13] + (size_t)l * DI, 32, r, scr, lane); continue; } r -= I_BR;
        if (r < 4 * I_PL) { const int g = r / I_PL; transpose_item(a.in[15] + ((size_t)l * 4 + g) * 512 * 512, 512, 0, 512, (bf16*)(wl + WL_WPOOL), g * 512, nullptr, 8, r % I_PL, scr, lane); continue; } r -= 4 * I_PL;
        if (r < I_OUT) { transpose_item(a.in[17] + (size_t)l * DM * DM, DM, 0, DM, (bf16*)(wl + WL_WOUT), 0, nullptr, 32, r, scr, lane); continue; } r -= I_OUT;
        if (r < I_UP) { transpose_item(a.in[20] + (size_t)l * DM * 2 * DFF, 2 * DFF, 0, DM, (bf16*)(wl + WL_WUP), 0, nullptr, 172, r, scr, lane); continue; } r -= I_UP;
        transpose_item(a.in[23] + (size_t)l * DFF * DM, DM, 0, DFF, (bf16*)(wl + WL_WDOWN), 0, nullptr, 32, r, scr, lane);
    }
    bf16* XB = (bf16*)(a.ws + WS_XB);
    for (int i = gt; i < MT * (DM / 8); i += NGT) {
        const int row = i / (DM / 8), c8 = (i % (DM / 8)) * 8;
        const float* src = (row < MP ? a.in[0] + (size_t)row * DM : a.in[1] + (size_t)(row - MP) * DM) + c8;
        const f32x4 v0 = *(const f32x4*)src, v1 = *(const f32x4*)(src + 4);
        v4u o; o.x = pk2(v0[0], v0[1]); o.y = pk2(v0[2], v0[3]); o.z = pk2(v1[0], v1[1]); o.w = pk2(v1[2], v1[3]);
        *(v4u*)(XB + (size_t)row * DM + c8) = o;
    }
}

__device__ __forceinline__ void ld8bf(const bf16* p, float (&v)[8]) { const v4u w = *(const v4u*)p; v[0] = bflo(w.x); v[1] = bfhi(w.x); v[2] = bflo(w.y); v[3] = bfhi(w.y); v[4] = bflo(w.z); v[5] = bfhi(w.z); v[6] = bflo(w.w); v[7] = bfhi(w.w); }
__device__ __forceinline__ void ld8f(const float* p, float (&v)[8]) { const f32x4 a0 = *(const f32x4*)p, a1 = *(const f32x4*)(p + 4); v[0] = a0[0]; v[1] = a0[1]; v[2] = a0[2]; v[3] = a0[3]; v[4] = a1[0]; v[5] = a1[1]; v[6] = a1[2]; v[7] = a1[3]; }
__device__ __forceinline__ void st8f(float* p, const float (&v)[8]) { *(f32x4*)p = (f32x4){v[0], v[1], v[2], v[3]}; *(f32x4*)(p + 4) = (f32x4){v[4], v[5], v[6], v[7]}; }
__device__ __forceinline__ void phase_a2(const Args& a, int l, int vcu, int G, int tid, int lane, int gw, int NGW, int gt, int NGT) {
    const bf16* PROJ = (const bf16*)(a.ws + WS_PROJ); bf16* XC = (bf16*)(a.ws + WS_XC);
    const float* DT = (const float*)(a.ws + WS_DT); float* DTS = (float*)(a.ws + WS_DTS); float* ACUM = (float*)(a.ws + WS_ACUM); float* WJ = (float*)(a.ws + WS_WJ);
    const float* cw = a.in[8] + (size_t)l * 4 * CD; const float* cb = a.in[9] + (size_t)l * CD;
    const float* stc = a.in[3] + (size_t)l * NDEC * 3 * CD;
    for (int r3_ = 0; r3_ < (((REP_MASK >> 15) & 1) ? 2 : 1); ++r3_)
    for (int ch = tid; ch < CD / 4; ch += 512) {
        const int c4 = 4 * ch;
        f32x4 w[4];
#pragma unroll
        for (int j = 0; j < 4; ++j) w[j] = *(const f32x4*)(cw + (size_t)j * CD + c4);
        const f32x4 bias = *(const f32x4*)(cb + c4);
        for (int r = vcu; r < MP / 32; r += G) {
            const int row0 = 32 * r, t0 = row0 & (SEQ - 1);
            v2u raw[35];
#pragma unroll
            for (int k = 0; k < 35; ++k) { const int rr = (t0 - 3 + k) >= 0 ? row0 - 3 + k : row0; raw[k] = *(const v2u*)(PROJ + (size_t)rr * LDPJ + PC_XBC + c4); }
            if (t0 == 0) { raw[0] = (v2u){0u, 0u}; raw[1] = (v2u){0u, 0u}; raw[2] = (v2u){0u, 0u}; }
#pragma unroll
            for (int e = 0; e < 32; ++e) { f32x4 y = bias + w[0] * bf4(raw[e]) + w[1] * bf4(raw[e + 1]) + w[2] * bf4(raw[e + 2]) + w[3] * bf4(raw[e + 3]);
#pragma unroll
                for (int q = 0; q < 4; ++q) y[q] = siluf(y[q]);
                *(v2u*)(XC + (size_t)(row0 + e) * CD + c4) = pk4(y); }
        }
        for (int s = vcu; s < NDEC; s += G) {
            f32x4 y = bias;
#pragma unroll
            for (int j = 0; j < 3; ++j) y += w[j] * *(const f32x4*)(stc + ((size_t)s * 3 + j) * CD + c4);
            y += w[3] * bf4(*(const v2u*)(PROJ + (size_t)(MP + s) * LDPJ + PC_XBC + c4));
#pragma unroll
            for (int q = 0; q < 4; ++q) y[q] = siluf(y[q]);
            *(v2u*)(XC + (size_t)(MP + s) * CD + c4) = pk4(y);
        }
    }
    for (int r4_ = 0; r4_ < (((REP_MASK >> 16) & 1) ? 2 : 1); ++r4_) {
    for (int task = gw; task < NB * (SEQ / 128) * NH; task += NGW) {
        const int h = task & 63; const size_t row0 = (size_t)(task >> 6) * 128;
        const float a_h = -expf(a.in[11][l * NH + h]), dtb = a.in[10][l * NH + h];
        const float d0 = softplusf(DT[(row0 + 2 * lane) * 64 + h] + dtb), d1 = softplusf(DT[(row0 + 2 * lane + 1) * 64 + h] + dtb);
        const float a0 = d0 * a_h, a1 = d1 * a_h; float s = a0 + a1;
#pragma unroll
        for (int o = 1; o < 64; o <<= 1) { const float t = __shfl_up(s, o); if (lane >= o) s += t; }
        const float aend = __shfl(s, 63), ac0 = s - a1, ac1 = s;
        DTS[(row0 + 2 * lane) * 64 + h] = d0; DTS[(row0 + 2 * lane + 1) * 64 + h] = d1;
        ACUM[(row0 + 2 * lane) * 64 + h] = ac0; ACUM[(row0 + 2 * lane + 1) * 64 + h] = ac1;
        WJ[(row0 + 2 * lane) * 64 + h] = d0 * __expf(aend - ac0); WJ[(row0 + 2 * lane + 1) * 64 + h] = d1 * __expf(aend - ac1);
    }
    for (int i = gt; i < NDEC * NH; i += NGT) { const size_t o = (size_t)MP * 64 + i; DTS[o] = softplusf(DT[o] + a.in[10][l * NH + (i & 63)]); }
    bf16* POOLED = (bf16*)(a.ws + WS_POOLED);
    const float* stp = a.in[4] + (size_t)l * NDEC * PB * DP;
    float* op = a.out + O_POOL_P + (size_t)l * NB * PB * DP; float* os = a.out + O_POOL_S + (size_t)l * NDEC * PB * DP;
    for (int i = gt; i < (MP / 8) * (DP / 8); i += NGT) {
        const int run = i >> 8, c8 = (i & 255) * 8, win = 2 << (c8 >> 9);
        const int row0 = 8 * run, t0 = row0 & (SEQ - 1);
        const bf16* pp = PROJ + (size_t)row0 * LDPJ + PC_POOL + c8;
        float sum[8], u[8], x[8];
#pragma unroll
        for (int e = 0; e < 8; ++e) sum[e] = 0.f;
#pragma unroll
        for (int k = 1; k < 16; ++k) { if (k < win) { const bool ok = k <= t0; ld8bf(pp - (size_t)(ok ? k : 0) * LDPJ, x);
#pragma unroll
            for (int e = 0; e < 8; ++e) sum[e] += ok ? x[e] : 0.f; } }
#pragma unroll
        for (int j = 0; j < 8; ++j) {
            const int t = t0 + j;
            ld8bf(pp + (size_t)j * LDPJ, u);
#pragma unroll
            for (int e = 0; e < 8; ++e) sum[e] += u[e];
            const int cnt = (t + 1 < win) ? t + 1 : win; const float inv = 1.f / (float)cnt;
            v4u o; o.x = pk2(sum[0] * inv - u[0], sum[1] * inv - u[1]); o.y = pk2(sum[2] * inv - u[2], sum[3] * inv - u[3]); o.z = pk2(sum[4] * inv - u[4], sum[5] * inv - u[5]); o.w = pk2(sum[6] * inv - u[6], sum[7] * inv - u[7]);
            *(v4u*)(POOLED + (size_t)(row0 + j) * DP + c8) = o;
            if (t >= SEQ - PB) st8f(op + ((size_t)(row0 >> 11) * PB + (t - (SEQ - PB))) * DP + c8, u);
            const bool ok = (t + 1 - win) >= 0; ld8bf(pp + ((ptrdiff_t)j + 1 - (ok ? win : 0)) * (ptrdiff_t)LDPJ, x);
#pragma unroll
            for (int e = 0; e < 8; ++e) sum[e] -= ok ? x[e] : 0.f;
        }
    }
    for (int i = gt; i < NDEC * (DP / 8); i += NGT) {
        const int s = i >> 8, c8 = (i & 255) * 8, win = 2 << (c8 >> 9), row = MP + s;
        float u[8], sum[8], x[8]; ld8bf(PROJ + (size_t)row * LDPJ + PC_POOL + c8, u);
#pragma unroll
        for (int e = 0; e < 8; ++e) sum[e] = u[e];
#pragma unroll
        for (int k = 1; k < 16; ++k) { ld8f(stp + ((size_t)s * PB + (PB - k)) * DP + c8, x); if (k < PB) st8f(os + ((size_t)s * PB + (PB - 1 - k)) * DP + c8, x);
            if (k < win) {
#pragma unroll
                for (int e = 0; e < 8; ++e) sum[e] += x[e]; } }
        st8f(os + ((size_t)s * PB + PB - 1) * DP + c8, u);
        const float inv = 1.f / (float)win;
        v4u o; o.x = pk2(sum[0] * inv - u[0], sum[1] * inv - u[1]); o.y = pk2(sum[2] * inv - u[2], sum[3] * inv - u[3]); o.z = pk2(sum[4] * inv - u[4], sum[5] * inv - u[5]); o.w = pk2(sum[6] * inv - u[6], sum[7] * inv - u[7]);
        *(v4u*)(POOLED + (size_t)row * DP + c8) = o;
    }
    float* ocp = a.out + O_CONV_P + (size_t)l * NB * 3 * CD; float* ocs = a.out + O_CONV_S + (size_t)l * NDEC * 3 * CD;
    for (int i = gt; i < (NB + NDEC) * 3 * (CD / 8); i += NGT) {
        const int c8 = (i % (CD / 8)) * 8, j = (i / (CD / 8)) % 3, q = i / (3 * (CD / 8));
        f32x4 v0, v1; float* o;
        if (q < NB) { const v4u w = *(const v4u*)(PROJ + (size_t)(q * SEQ + SEQ - 3 + j) * LDPJ + PC_XBC + c8); v0 = (f32x4){bflo(w.x), bfhi(w.x), bflo(w.y), bfhi(w.y)}; v1 = (f32x4){bflo(w.z), bfhi(w.z), bflo(w.w), bfhi(w.w)};
            o = ocp + ((size_t)q * 3 + j) * CD + c8; }
        else { const int s = q - NB; o = ocs + ((size_t)s * 3 + j) * CD + c8;
            if (j < 2) { const float* sp = stc + ((size_t)s * 3 + j + 1) * CD + c8; v0 = *(const f32x4*)sp; v1 = *(const f32x4*)(sp + 4); }
            else { const v4u w = *(const v4u*)(PROJ + (size_t)(MP + s) * LDPJ + PC_XBC + c8); v0 = (f32x4){bflo(w.x), bfhi(w.x), bflo(w.y), bfhi(w.y)}; v1 = (f32x4){bflo(w.z), bfhi(w.z), bflo(w.w), bfhi(w.w)}; } }
        *(f32x4*)o = v0; *(f32x4*)(o + 4) = v1;
    }
    }
}

constexpr int SP = 272, SPX = 144;
constexpr int L_CM = 0, L_BM = 128 * SP, L_XM = 2 * 128 * SP, L_XW = L_XM + 128 * SPX, L_SB = L_XW + 128 * SPX, L_DTV = L_SB + 64 * SP, L_ACUM = L_DTV + 512, L_SSD_END = L_ACUM + 512;
static_assert(L_SSD_END <= MISC_OFF, "SSD LDS map");
typedef short s16x4 __attribute__((ext_vector_type(4)));
__device__ __forceinline__ bf16x8 tr_pair(LAS unsigned char* p0, LAS unsigned char* p1) {
    const s16x4 lo = __builtin_amdgcn_ds_read_tr16_b64_v4i16((LAS s16x4*)p0), hi = __builtin_amdgcn_ds_read_tr16_b64_v4i16((LAS s16x4*)p1);
    return __builtin_shufflevector(lo, hi, 0, 1, 2, 3, 4, 5, 6, 7);
}

template <bool DEC>
__device__ __forceinline__ void ssd_prompt_unit(const Args& a, LAS unsigned char* lds, int l, int b, int h, int tid, int wave, int lane, int dq0, int dqs) {
    const bf16* PROJ = (const bf16*)(a.ws + WS_PROJ); const bf16* XC = (const bf16*)(a.ws + WS_XC);
    const float* DTS = (const float*)(a.ws + WS_DTS); const float* ACUM = (const float*)(a.ws + WS_ACUM); const float* WJ = (const float*)(a.ws + WS_WJ);
    bf16* V = (bf16*)(a.ws + WS_V); float* SSQ = (float*)(a.ws + WS_SSQ);
    const float Dh = a.in[12][l * NH + h];
    const int g = h >> 3, l15 = lane & 15, g4 = lane >> 4, w = wave;
    LAS float* dtv = (LAS float*)(lds + L_DTV); LAS float* acum = (LAS float*)(lds + L_ACUM);
    v4u pc[4], pb[4], px[2]; float pwj[2], pda = 0.f; v2u pz[4];
#define SSD_PREFETCH(c_) do { const size_t r0_ = (size_t)b * SEQ + 128 * (c_); \
        _Pragma("unroll") for (int k = 0; k < 4; ++k) { const int q = tid + 512 * k, row = q >> 4, pcn = q & 15; \
            pc[k] = *(const v4u*)(XC + (r0_ + row) * CD + DI + NG * DS + g * DS + 8 * pcn); pb[k] = *(const v4u*)(XC + (r0_ + row) * CD + DI + g * DS + 8 * pcn); } \
        _Pragma("unroll") for (int k = 0; k < 2; ++k) { const int q = tid + 512 * k, row = q >> 3, pcn = q & 7; \
            px[k] = *(const v4u*)(XC + (r0_ + row) * CD + h * HD + 8 * pcn); pwj[k] = WJ[(r0_ + row) * 64 + h]; } \
        if (tid < 128) pda = DTS[(r0_ + tid) * 64 + h]; else if (tid < 256) pda = ACUM[(r0_ + tid - 128) * 64 + h]; \
        } while (0)
#define SSD_LOADZ(c_) do { const size_t r0_ = (size_t)b * SEQ + 128 * (c_); \
        _Pragma("unroll") for (int pt = 0; pt < 4; ++pt) pz[pt] = *(const v2u*)(PROJ + (r0_ + 16 * w + l15) * LDPJ + PC_Z + h * HD + 16 * pt + 4 * g4); } while (0)
    f32x4 ds4[8]; f32x4 dB4 = {0.f, 0.f, 0.f, 0.f}, dC4 = {0.f, 0.f, 0.f, 0.f}; float dxc = 0.f, ddt = 0.f, ddA = 0.f, dz = 0.f, dyv = 0.f, dDh = 0.f;
    const int n4 = 4 * (lane & 31);
#define DEC_HDR(k_) do { const int q_ = dq0 + (k_) * dqs, s_ = q_ >> 6, h_ = q_ & 63; const bf16* xrow_ = XC + (size_t)(MP + s_) * CD; \
        dxc = bf1(xrow_[h_ * HD + lane]); dB4 = bf4(*(const v2u*)(xrow_ + DI + (h_ >> 3) * DS + n4)); dC4 = bf4(*(const v2u*)(xrow_ + DI + NG * DS + (h_ >> 3) * DS + n4)); \
        ddt = DTS[(size_t)(MP + s_) * 64 + h_]; ddA = __expf(ddt * -expf(a.in[11][l * NH + h_])); dDh = a.in[12][l * NH + h_]; \
        dz = bf1(PROJ[(size_t)(MP + s_) * LDPJ + PC_Z + h_ * HD + lane]); dyv = 0.f; } while (0)
#define DEC_LOAD(c_) do { const int q_ = dq0 + ((c_) >> 2) * dqs; const float* sin_ = a.in[2] + ((size_t)l * NDEC * NH + q_) * HD * DS; \
        _Pragma("unroll") for (int i = 0; i < 8; ++i) ds4[i] = *(const f32x4*)(sin_ + (size_t)(((c_) & 3) * 8 + i + (lane & 32)) * DS + n4); } while (0)
    if (DEC) { DEC_HDR(0); DEC_LOAD(0); }
    SSD_PREFETCH(0);
    f32x4 sacc[4];
#pragma unroll
    for (int pt = 0; pt < 4; ++pt) sacc[pt] = (f32x4){0.f, 0.f, 0.f, 0.f};
    for (int i = tid; i < 64 * SP / 4; i += 512) ((LAS unsigned*)(lds + L_SB))[i] = 0u;
    for (int c = 0; c < SEQ / 128; ++c) {
        const int tc = c * 128;
#pragma unroll
        for (int k = 0; k < 4; ++k) { const int q = tid + 512 * k, row = q >> 4, pcn = q & 15; *(LAS v4u*)(lds + L_CM + row * SP + 16 * pcn) = pc[k]; *(LAS v4u*)(lds + L_BM + row * SP + 16 * pcn) = pb[k]; }
#pragma unroll
        for (int k = 0; k < 2; ++k) { const int q = tid + 512 * k, row = q >> 3, pcn = q & 7; const float wj = pwj[k]; const v4u x = px[k];
            *(LAS v4u*)(lds + L_XM + row * SPX + 16 * pcn) = x;
            v4u xw; xw.x = pk2(bflo(x.x) * wj, bfhi(x.x) * wj); xw.y = pk2(bflo(x.y) * wj, bfhi(x.y) * wj); xw.z = pk2(bflo(x.z) * wj, bfhi(x.z) * wj); xw.w = pk2(bflo(x.w) * wj, bfhi(x.w) * wj);
            *(LAS v4u*)(lds + L_XW + row * SPX + 16 * pcn) = xw; }
        if (tid < 256) dtv[tid] = pda;
        if (DEC) {
            const int q_ = dq0 + (c >> 2) * dqs; float* sout_ = a.out + O_SSM_S + ((size_t)l * NDEC * NH + q_) * HD * DS;
#pragma unroll
            for (int i = 0; i < 8; ++i) {
                const int it = (c & 3) * 8 + i, p = it + (lane & 32);
                f32x4 S4 = ds4[i];
                const float xp = __shfl(dxc, p);
                S4 = S4 * ddA + dB4 * (ddt * xp);
                float part = (dC4[0] * S4[0] + dC4[1] * S4[1]) + (dC4[2] * S4[2] + dC4[3] * S4[3]);
                *(f32x4*)(sout_ + (size_t)p * DS + n4) = S4;
#pragma unroll
                for (int o = 1; o < 32; o <<= 1) part += __shfl_xor(part, o);
                if ((lane & 31) == it) dyv = part;
            }
            if ((c & 3) == 3) {
                const int s_ = q_ >> 6, h_ = q_ & 63;
                const float v = (dyv + dDh * dxc) * siluf(dz);
                const float ss = wave_sum(v * v);
                if (lane == 0) SSQ[(size_t)(MP + s_) * 64 + h_] = ss;
                V[(size_t)(MP + s_) * DI + h_ * HD + lane] = (bf16)(pk2(v, 0.f) & 0xffffu);
            }
        }
        LDS_BARRIER();
        SSD_LOADZ(c);
        if (c + 1 < SEQ / 128) { SSD_PREFETCH(c + 1); if (DEC) { if (((c + 1) & 3) == 0) DEC_HDR((c + 1) >> 2); DEC_LOAD(c + 1); } }
        {
            bf16x8 cf[4];
#pragma unroll
            for (int ks = 0; ks < 4; ++ks) cf[ks] = *(const LAS bf16x8*)(lds + L_CM + (16 * w + l15) * SP + (32 * ks + 8 * g4) * 2);
            const float ai = acum[16 * w + l15];
            v2u gp[8];
#pragma unroll
            for (int jt = 0; jt < 8; ++jt) {
                gp[jt] = (v2u){0u, 0u};
                if (jt <= w) {
                    f32x4 acc = (f32x4){0.f, 0.f, 0.f, 0.f};
#pragma unroll
                    for (int ks = 0; ks < 4; ++ks) { const bf16x8 bfr = *(const LAS bf16x8*)(lds + L_BM + (16 * jt + l15) * SP + (32 * ks + 8 * g4) * 2);
                        acc = __builtin_amdgcn_mfma_f32_16x16x32_bf16(bfr, cf[ks], acc, 0, 0, 0); }
                    const f32x4 aj = *(const LAS f32x4*)(acum + 16 * jt + 4 * g4), dj = *(const LAS f32x4*)(dtv + 16 * jt + 4 * g4);
                    f32x4 m4;
#pragma unroll
                    for (int e = 0; e < 4; ++e) { const bool ok = (16 * jt + 4 * g4 + e) <= (16 * w + l15); m4[e] = ok ? acc[e] * __expf(ai - aj[e]) * dj[e] : 0.f; }
                    gp[jt] = pk4(m4);
                }
            }
            f32x4 ya[4];
            const float eai = __expf(ai);
#pragma unroll
            for (int pt = 0; pt < 4; ++pt) {
                f32x4 acc = (f32x4){0.f, 0.f, 0.f, 0.f};
#pragma unroll
                for (int ks = 0; ks < 4; ++ks) { const bf16x8 sf = *(const LAS bf16x8*)(lds + L_SB + (16 * pt + l15) * SP + (32 * ks + 8 * g4) * 2);
                    acc = __builtin_amdgcn_mfma_f32_16x16x32_bf16(sf, cf[ks], acc, 0, 0, 0); }
                ya[pt] = acc * eai;
            }
#pragma unroll
            for (int s = 0; s < 4; ++s) {
                if (2 * s <= w) {
                    bf16x8 mf; { const v2u lo = gp[2 * s], hi = gp[2 * s + 1]; v4u m; m.x = lo.x; m.y = lo.y; m.z = hi.x; m.w = hi.y; mf = __builtin_bit_cast(bf16x8, m); }
#pragma unroll
                    for (int pt = 0; pt < 4; ++pt) {
                        LAS unsigned char* xp = lds + L_XM + (32 * s + 4 * g4 + (l15 >> 2)) * SPX + (16 * pt + 4 * (l15 & 3)) * 2;
                        ya[pt] = __builtin_amdgcn_mfma_f32_16x16x32_bf16(tr_pair(xp, xp + 16 * SPX), mf, ya[pt], 0, 0, 0);
                    }
                }
            }
            const size_t r = (size_t)b * SEQ + tc + 16 * w + l15;
            float ss = 0.f;
#pragma unroll
            for (int pt = 0; pt < 4; ++pt) {
                const f32x4 z = bf4(pz[pt]);
                const f32x4 xv = bf4(*(const LAS v2u*)(lds + L_XM + (16 * w + l15) * SPX + (16 * pt + 4 * g4) * 2));
                f32x4 v;
#pragma unroll
                for (int e = 0; e < 4; ++e) { v[e] = (ya[pt][e] + Dh * xv[e]) * siluf(z[e]); ss += v[e] * v[e]; }
                *(v2u*)(V + r * DI + h * HD + 16 * pt + 4 * g4) = pk4(v);
            }
            ss += __shfl_xor(ss, 16); ss += __shfl_xor(ss, 32);
            if (g4 == 0) SSQ[r * 64 + h] = ss;
        }
        LDS_BARRIER();
        {
            const float dec = __expf(acum[127]);
#pragma unroll
            for (int pt = 0; pt < 4; ++pt) sacc[pt] = sacc[pt] * dec;
#pragma unroll
            for (int ks = 0; ks < 4; ++ks) {
                LAS unsigned char* bp = lds + L_BM + (32 * ks + 8 * g4 + (l15 >> 2)) * SP + (16 * w + 4 * (l15 & 3)) * 2;
                const bf16x8 bw = tr_pair(bp, bp + 4 * SP);
#pragma unroll
                for (int pt = 0; pt < 4; ++pt) { LAS unsigned char* xp = lds + L_XW + (32 * ks + 8 * g4 + (l15 >> 2)) * SPX + (16 * pt + 4 * (l15 & 3)) * 2;
                    sacc[pt] = __builtin_amdgcn_mfma_f32_16x16x32_bf16(bw, tr_pair(xp, xp + 4 * SPX), sacc[pt], 0, 0, 0); }
            }
#pragma unroll
            for (int pt = 0; pt < 4; ++pt) *(LAS v2u*)(lds + L_SB + (16 * pt + l15) * SP + (16 * w + 4 * g4) * 2) = pk4(sacc[pt]);
        }
        LDS_BARRIER();
    }
#undef SSD_PREFETCH
#undef SSD_LOADZ
#undef DEC_HDR
#undef DEC_LOAD
    float* so = a.out + O_SSM_P + (((size_t)l * NB + b) * NH + h) * HD * DS;
#pragma unroll
    for (int pt = 0; pt < 4; ++pt) *(f32x4*)(so + (size_t)(16 * pt + l15) * DS + 16 * w + 4 * g4) = sacc[pt];
}

__device__ __forceinline__ void ssd_decode_pair(const Args& a, int l, int s, int h, int lane) {
    const bf16* PROJ = (const bf16*)(a.ws + WS_PROJ); const bf16* XC = (const bf16*)(a.ws + WS_XC); const float* DTS = (const float*)(a.ws + WS_DTS);
    bf16* V = (bf16*)(a.ws + WS_V); float* SSQ = (float*)(a.ws + WS_SSQ);
    const float a_h = -expf(a.in[11][l * NH + h]), Dh = a.in[12][l * NH + h];
    const int g = h >> 3, r = MP + s, n4 = 4 * (lane & 31);
    const bf16* xrow = XC + (size_t)r * CD;
    const float xc = bf1(xrow[h * HD + lane]);
    const f32x4 B4 = bf4(*(const v2u*)(xrow + DI + g * DS + n4)), C4 = bf4(*(const v2u*)(xrow + DI + NG * DS + g * DS + n4));
    const float dt = DTS[(size_t)r * 64 + h], dA = __expf(dt * a_h);
    const float* sin = a.in[2] + (((size_t)l * NDEC + s) * NH + h) * HD * DS;
    float* sout = a.out + O_SSM_S + (((size_t)l * NDEC + s) * NH + h) * HD * DS;
    float yv = 0.f;
#pragma unroll 8
    for (int it = 0; it < 32; ++it) {
        const int p = it + (lane & 32);
        f32x4 S4 = *(const f32x4*)(sin + (size_t)p * DS + n4);
        const float xp = __shfl(xc, p);
        S4 = S4 * dA + B4 * (dt * xp);
        float part = (C4[0] * S4[0] + C4[1] * S4[1]) + (C4[2] * S4[2] + C4[3] * S4[3]);
        *(f32x4*)(sout + (size_t)p * DS + n4) = S4;
#pragma unroll
        for (int o = 1; o < 32; o <<= 1) part += __shfl_xor(part, o);
        if ((lane & 31) == it) yv = part;
    }
    const float z = bf1(PROJ[(size_t)r * LDPJ + PC_Z + h * HD + lane]);
    const float v = (yv + Dh * xc) * siluf(z);
    const float ss = wave_sum(v * v);
    if (lane == 0) SSQ[(size_t)r * 64 + h] = ss;
    V[(size_t)r * DI + h * HD + lane] = (bf16)(pk2(v, 0.f) & 0xffffu);
}

__device__ __forceinline__ void phase_b2(const Args& a, int l, int gt, int NGT) {
    const bf16* V = (const bf16*)(a.ws + WS_V); const float* SSQ = (const float*)(a.ws + WS_SSQ); bf16* YN = (bf16*)(a.ws + WS_YN);
    for (int i = gt; i < MT * (DI / 8); i += NGT) {
        const int row = i >> 9, c8 = (i & 511) * 8, grp = c8 >> 9;
        const f32x4 q0 = *(const f32x4*)(SSQ + (size_t)row * 64 + grp * 8), q1 = *(const f32x4*)(SSQ + (size_t)row * 64 + grp * 8 + 4);
        const float rstd = rsqrtf(((q0[0] + q0[1]) + (q0[2] + q0[3]) + (q1[0] + q1[1]) + (q1[2] + q1[3])) * (1.f / 512.f) + RMS_EPS);
        const v4u u = *(const v4u*)(V + (size_t)row * DI + c8);
        v4u o; o.x = pk2(bflo(u.x) * rstd, bfhi(u.x) * rstd); o.y = pk2(bflo(u.y) * rstd, bfhi(u.y) * rstd); o.z = pk2(bflo(u.z) * rstd, bfhi(u.z) * rstd); o.w = pk2(bflo(u.w) * rstd, bfhi(u.w) * rstd);
        *(v4u*)(YN + (size_t)row * DI + c8) = o;
    }
}

__device__ __forceinline__ void phase_ln(const float* U, const float* g, const float* b, float* outf, bf16* outb, int gw, int NGW, int lane) {
    for (int row = gw; row < MT; row += NGW) {
        const float* ur = U + (size_t)row * DM + 4 * lane;
        f32x4 v[8]; float s = 0.f;
#pragma unroll
        for (int j = 0; j < 8; ++j) { v[j] = *(const f32x4*)(ur + 256 * j); s += (v[j][0] + v[j][1]) + (v[j][2] + v[j][3]); }
        const float mean = wave_sum(s) * (1.f / DM); float q = 0.f;
#pragma unroll
        for (int j = 0; j < 8; ++j) { v[j] = v[j] - mean; q += (v[j][0] * v[j][0] + v[j][1] * v[j][1]) + (v[j][2] * v[j][2] + v[j][3] * v[j][3]); }
        const float rstd = rsqrtf(wave_sum(q) * (1.f / DM) + LN_EPS);
#pragma unroll
        for (int j = 0; j < 8; ++j) {
            const f32x4 gg = *(const f32x4*)(g + 4 * lane + 256 * j), bb = *(const f32x4*)(b + 4 * lane + 256 * j);
            const f32x4 o = v[j] * rstd * gg + bb;
            *(f32x4*)(outf + (size_t)row * DM + 4 * lane + 256 * j) = o;
            if (outb) *(v2u*)(outb + (size_t)row * DM + 4 * lane + 256 * j) = pk4(o);
        }
    }
}

__device__ __forceinline__ void ffn_taps(const float* fw, const float* fb, int col, float (&w)[3][8], float (&bias)[8]) {
#pragma unroll
    for (int j = 0; j < 3; ++j) { const f32x4 a0 = *(const f32x4*)(fw + (size_t)j * 2 * DFF + col), a1 = *(const f32x4*)(fw + (size_t)j * 2 * DFF + col + 4);
        w[j][0] = a0[0]; w[j][1] = a0[1]; w[j][2] = a0[2]; w[j][3] = a0[3]; w[j][4] = a1[0]; w[j][5] = a1[1]; w[j][6] = a1[2]; w[j][7] = a1[3]; }
    const f32x4 b0 = *(const f32x4*)(fb + col), b1 = *(const f32x4*)(fb + col + 4);
    bias[0] = b0[0]; bias[1] = b0[1]; bias[2] = b0[2]; bias[3] = b0[3]; bias[4] = b1[0]; bias[5] = b1[1]; bias[6] = b1[2]; bias[7] = b1[3];
}
__device__ __forceinline__ void phase_e2(const Args& a, int l, int vcu, int G, int tid) {
    const bf16* HPRE = (const bf16*)(a.ws + WS_HPRE); bf16* HACT = (bf16*)(a.ws + WS_HACT);
    const float* fw = a.in[21] + (size_t)l * 3 * 2 * DFF; const float* fb = a.in[22] + (size_t)l * 2 * DFF;
    const float* stf = a.in[5] + (size_t)l * NDEC * 2 * 2 * DFF;
    float* ofp = a.out + O_FFN_P + (size_t)l * NB * 2 * 2 * DFF; float* ofs = a.out + O_FFN_S + (size_t)l * NDEC * 2 * 2 * DFF;
    for (int ch = tid; ch < DFF / 8; ch += 512) {
        const int c8 = ch * 8;
        float wg[3][8], bg_[8], wv[3][8], bv[8];
        ffn_taps(fw, fb, c8, wg, bg_); ffn_taps(fw, fb, DFF + c8, wv, bv);
        for (int rb = vcu; rb < MP / 32; rb += G) {
        const int r0 = 32 * rb, t0 = r0 & (SEQ - 1);
        float g2[8], g1[8], v2[8], v1[8];
#pragma unroll
        for (int e = 0; e < 8; ++e) { g2[e] = 0.f; g1[e] = 0.f; v2[e] = 0.f; v1[e] = 0.f; }
        if (t0 >= 2) { ld8bf(HPRE + (size_t)(r0 - 2) * 2 * DFF + c8, g2); ld8bf(HPRE + (size_t)(r0 - 2) * 2 * DFF + DFF + c8, v2);
                       ld8bf(HPRE + (size_t)(r0 - 1) * 2 * DFF + c8, g1); ld8bf(HPRE + (size_t)(r0 - 1) * 2 * DFF + DFF + c8, v1); }
        for (int i4 = 0; i4 < 32; i4 += 4) {
            v4u gq[4], vq[4];
#pragma unroll
            for (int q = 0; q < 4; ++q) { gq[q] = *(const v4u*)(HPRE + (size_t)(r0 + i4 + q) * 2 * DFF + c8); vq[q] = *(const v4u*)(HPRE + (size_t)(r0 + i4 + q) * 2 * DFF + DFF + c8); }
#pragma unroll
            for (int q = 0; q < 4; ++q) {
                const int r = r0 + i4 + q;
                const float g0[8] = {bflo(gq[q].x), bfhi(gq[q].x), bflo(gq[q].y), bfhi(gq[q].y), bflo(gq[q].z), bfhi(gq[q].z), bflo(gq[q].w), bfhi(gq[q].w)};
                const float v0[8] = {bflo(vq[q].x), bfhi(vq[q].x), bflo(vq[q].y), bfhi(vq[q].y), bflo(vq[q].z), bfhi(vq[q].z), bflo(vq[q].w), bfhi(vq[q].w)};
                float o[8];
#pragma unroll
                for (int e = 0; e < 8; ++e) { const float hg = bg_[e] + wg[0][e] * g2[e] + wg[1][e] * g1[e] + wg[2][e] * g0[e], hv = bv[e] + wv[0][e] * v2[e] + wv[1][e] * v1[e] + wv[2][e] * v0[e]; o[e] = siluf(hg) * hv; }
                v4u w; w.x = pk2(o[0], o[1]); w.y = pk2(o[2], o[3]); w.z = pk2(o[4], o[5]); w.w = pk2(o[6], o[7]);
                *(v4u*)(HACT + (size_t)r * DFF + c8) = w;
#pragma unroll
                for (int e = 0; e < 8; ++e) { g2[e] = g1[e]; g1[e] = g0[e]; v2[e] = v1[e]; v1[e] = v0[e]; }
            }
        }
        if (t0 + 32 == SEQ) { float* o2 = ofp + (size_t)(r0 >> 11) * 2 * 2 * DFF; st8f(o2 + c8, g2); st8f(o2 + DFF + c8, v2); st8f(o2 + 2 * DFF + c8, g1); st8f(o2 + 2 * DFF + DFF + c8, v1); }
        }
        for (int s = vcu; s < NDEC; s += G) {
            const int r = MP + s;
            float g2[8], g1[8], v2[8], v1[8];
            const float* sp = stf + (size_t)s * 2 * 2 * DFF;
            ld8f(sp + c8, g2); ld8f(sp + DFF + c8, v2); ld8f(sp + 2 * DFF + c8, g1); ld8f(sp + 2 * DFF + DFF + c8, v1);
            float g0[8], v0[8]; ld8bf(HPRE + (size_t)r * 2 * DFF + c8, g0); ld8bf(HPRE + (size_t)r * 2 * DFF + DFF + c8, v0);
            float o[8];
#pragma unroll
            for (int e = 0; e < 8; ++e) { const float hg = bg_[e] + wg[0][e] * g2[e] + wg[1][e] * g1[e] + wg[2][e] * g0[e], hv = bv[e] + wv[0][e] * v2[e] + wv[1][e] * v1[e] + wv[2][e] * v0[e]; o[e] = siluf(hg) * hv; }
            v4u w; w.x = pk2(o[0], o[1]); w.y = pk2(o[2], o[3]); w.z = pk2(o[4], o[5]); w.w = pk2(o[6], o[7]);
            *(v4u*)(HACT + (size_t)r * DFF + c8) = w;
            float* o2 = ofs + (size_t)s * 2 * 2 * DFF; st8f(o2 + c8, g1); st8f(o2 + DFF + c8, v1); st8f(o2 + 2 * DFF + c8, g0); st8f(o2 + 2 * DFF + DFF + c8, v0);
        }
    }
}

constexpr int PH_PER_LAYER = 12, N_PHASES = 1 + DEPTH * PH_PER_LAYER;
#ifndef MK_PER_PHASE
#define MK_PER_PHASE 0
#endif

__global__ void __launch_bounds__(NWAVES * 64, 2) mega_fwd(Args args) {
    extern __shared__ __attribute__((aligned(16))) unsigned char lds_raw[];
    LAS unsigned char* lds = (LAS unsigned char*)lds_raw;
    volatile LAS unsigned* MISC = (volatile LAS unsigned*)(lds + MISC_OFF);
    const int tid = threadIdx.x, lane = tid & 63, wave = __builtin_amdgcn_readfirstlane(tid >> 6);
    const int G = gridDim.x, bx = blockIdx.x, vcu = (G % 8 == 0) ? (bx % 8) * (G / 8) + bx / 8 : bx;
    const int gw = vcu * NWAVES + wave, NGW = G * NWAVES, gt = vcu * 512 + tid, NGT = G * 512;
    for (int u = tid; u < (LDS_BYTES - MISC_OFF) / 4; u += NWAVES * 64) ((LAS unsigned*)(lds + MISC_OFF))[u] = 0u;
    __syncthreads();
    unsigned* ctl = (unsigned*)(args.ws + WS_CTL);
    XcdBarrier bar; bar.bar = ctl + CW_BAR; bar.x = 0; bar.st = nullptr;
    if (!MK_PER_PHASE) bar = xcd_barrier_post(ctl + CW_BAR, MISC + 8);
    const int lo = args.ph_lo, hi = args.ph_hi;
#define IN(k) (lo <= (k) && (k) < hi)
#define REPS(k) for (int rep_ = 0; rep_ < (((REP_MASK >> (k)) & 1) ? 2 : 1); ++rep_)
#define REP_BAR(k) do { if (((REP_MASK >> (k)) & 1) && rep_ == 0 && !MK_PER_PHASE) xcd_barrier(bar); } while (0)
#define SEAM(k) do { if (!MK_PER_PHASE && IN((k) + 1)) xcd_barrier(bar); } while (0)

#define PH_IDS int tidp = tid; asm volatile("" : "+v"(tidp)); int vcup = vcu; asm volatile("" : "+s"(vcup)); const int lanep = tidp & 63, wavep = __builtin_amdgcn_readfirstlane(tidp >> 6); \
    const int gwp = vcup * NWAVES + wavep, gtp = vcup * 512 + tidp; (void)lanep; (void)wavep; (void)gwp; (void)gtp;
    if (IN(0)) { REPS(12) { const Args& a = fresh_args(); PH_IDS p0_prologue(a, lds, gwp, NGW, gtp, NGT, wavep, lanep); REP_BAR(12); } SEAM(0); }

#define WSP(T, off) ((T*)(a.ws + (off)))
#define WLP(off) ((const bf16*)(a.ws + WS_W + (size_t)l * WL_SIZE + (off)))
    for (int l = 0; l < DEPTH; ++l) {
        const int P = 1 + l * PH_PER_LAYER;
        if (IN(P + 0)) { REPS(0) {
            const Args& a = fresh_args(); PH_IDS
            bf16* XB = WSP(bf16, WS_XB); bf16* PROJ = WSP(bf16, WS_PROJ); const bf16* WIN = WLP(WL_WIN);
            { pg8::Gemm g{XB, WIN, MP, NPROJ, DM, DM, DM, 1 << 30, 0}; pg8::StaticOrder S; S.init(MP, NPROJ, G, bx);
              pg8::EpiBf16<0> E{PROJ, LDPJ, nullptr, 0, 0, 1.f};
              pg8::gemm_phase<pg8::EpiBf16<0>, pg8::StaticOrder, true, true>(lds, g, S, E, tidp); }
            __syncthreads();
            const FProj f{PROJ, WSP(float, WS_DT)};
            for (int r5_ = 0; r5_ < (((REP_MASK >> 19) & 1) ? 2 : 1); ++r5_)
            for (int u = vcup; u < 257 + 64; u += G) {
                if (u < 257) skinny_unit<4>(lds, XB + (size_t)MP * DM, DM, WIN + (size_t)u * 64 * DM, DM, DM, MP, 64 * u, f, wavep, lanep);
                else skinny_unit<4>(lds, XB + (size_t)(u - 257) * 128 * DM, DM, WIN + (size_t)NPROJ * DM, DM, DM, (u - 257) * 128, NPROJ, f, wavep, lanep);
            }
            REP_BAR(0); }
            SEAM(P + 0);
        }
        if (IN(P + 1)) { REPS(1) { const Args& a = fresh_args(); PH_IDS phase_a2(a, l, vcup, G, tidp, lanep, gwp, NGW, gtp, NGT); REP_BAR(1); } SEAM(P + 1); }
        if (IN(P + 2)) { REPS(2) {
            const Args& a = fresh_args(); PH_IDS
            if (G * 4 * NWAVES == NDEC * NH && G == NB * NH) {
                ssd_prompt_unit<true>(a, lds, l, vcup / NH, vcup % NH, tidp, wavep, lanep, gwp, NGW);
            } else {
                for (int u = vcup; u < NB * NH; u += G) ssd_prompt_unit<false>(a, lds, l, u / NH, u % NH, tidp, wavep, lanep, 0, 0);
                for (int q = gwp; q < NDEC * NH; q += NGW) ssd_decode_pair(a, l, q / NH, q % NH, lanep);
            }
            REP_BAR(2); }
            SEAM(P + 2);
        }
        if (IN(P + 3)) { REPS(3) { const Args& a = fresh_args(); PH_IDS phase_b2(a, l, gtp, NGT); REP_BAR(3); } SEAM(P + 3); }
        if (IN(P + 4)) { REPS(4) {
            const Args& a = fresh_args(); PH_IDS
            const bf16* POOLED = WSP(bf16, WS_POOLED); const bf16* WPOOL = WLP(WL_WPOOL);
            const FYb f{a.in[16] + (size_t)l * DP, WSP(bf16, WS_YB)};
            { pg8::Gemm g{POOLED, WPOOL, MP, DM, 512, DP, 512, 2, 512}; pg8::StaticOrder S; S.init(MP, DM, G, bx);
              Epi4<FYb> E{f}; pg8::gemm_phase<Epi4<FYb>, pg8::StaticOrder, true, true>(lds, g, S, E, tidp); }
            __syncthreads();
            for (int u = vcup; u < 128; u += G) skinny_unit<1>(lds, POOLED + (size_t)MP * DP + (u / 32) * 512, DP, WPOOL + (size_t)u * 16 * 512, 512, 512, MP, 16 * u, f, wavep, lanep);
            REP_BAR(4); }
            SEAM(P + 4);
        }
        if (IN(P + 5)) { REPS(5) {
            const Args& a = fresh_args(); PH_IDS
            const bf16* YN = WSP(bf16, WS_YN); const bf16* WBR = WLP(WL_WBR);
            const FMix f{WSP(bf16, WS_PROJ), a.in[7] + (size_t)l * 2 * DM, WSP(bf16, WS_YB), WSP(bf16, WS_MIX)};
            { pg8::Gemm g{YN, WBR, MP, DM, DI, DI, DI, 1 << 30, 0}; pg8::StaticOrder S; S.init(MP, DM, G, bx);
              Epi4<FMix> E{f}; pg8::gemm_phase<Epi4<FMix>, pg8::StaticOrder, true, true>(lds, g, S, E, tidp); }
            __syncthreads();
            for (int r5_ = 0; r5_ < (((REP_MASK >> 17) & 1) ? 2 : 1); ++r5_)
            for (int u = vcup; u < 128; u += G) skinny_unit<1>(lds, YN + (size_t)MP * DI, DI, WBR + (size_t)u * 16 * DI, DI, DI, MP, 16 * u, f, wavep, lanep);
            REP_BAR(5); }
            SEAM(P + 5);
        }
        if (IN(P + 6)) { REPS(6) {
            const Args& a = fresh_args(); PH_IDS
            const bf16* MIX = WSP(bf16, WS_MIX); const bf16* WOUT = WLP(WL_WOUT);
            RowSrc xsrc; if (l == 0) { xsrc.p = a.in[0]; xsrc.s = a.in[1]; } else { xsrc.p = WSP(float, WS_XF); xsrc.s = WSP(float, WS_XF) + (size_t)MP * DM; }
            const FRes f{xsrc, WSP(float, WS_U)};
            { pg8::Gemm g{MIX, WOUT, MP, DM, DM, DM, DM, 1 << 30, 0}; pg8::StaticOrder S; S.init(MP, DM, G, bx);
              Epi4<FRes> E{f}; pg8::gemm_phase<Epi4<FRes>, pg8::StaticOrder, true, true>(lds, g, S, E, tidp); }
            __syncthreads();
            for (int u = vcup; u < 128; u += G) skinny_unit<1>(lds, MIX + (size_t)MP * DM, DM, WOUT + (size_t)u * 16 * DM, DM, DM, MP, 16 * u, f, wavep, lanep);
            REP_BAR(6); }
            SEAM(P + 6);
        }
        if (IN(P + 7)) { REPS(7) { const Args& a = fresh_args(); PH_IDS phase_ln(WSP(float, WS_U), a.in[18] + (size_t)l * DM, a.in[19] + (size_t)l * DM, WSP(float, WS_X1F), WSP(bf16, WS_X1B), gwp, NGW, lanep); REP_BAR(7); } SEAM(P + 7); }
        if (IN(P + 8)) { REPS(8) {
            const Args& a = fresh_args(); PH_IDS
            const bf16* X1B = WSP(bf16, WS_X1B); const bf16* WUP = WLP(WL_WUP); bf16* HPRE = WSP(bf16, WS_HPRE);
            { pg8::Gemm g{X1B, WUP, MP, 2 * DFF, DM, DM, DM, 1 << 30, 0}; pg8::StaticOrder S; S.init(MP, 2 * DFF, G, bx);
              pg8::EpiBf16<0> E{HPRE, 2 * DFF, nullptr, 0, 0, 1.f};
              pg8::gemm_phase<pg8::EpiBf16<0>, pg8::StaticOrder, true, true>(lds, g, S, E, tidp); }
            __syncthreads();
            const FBf f{HPRE, 2 * DFF};
            for (int u = vcup; u < 172; u += G) skinny_unit<4>(lds, X1B + (size_t)MP * DM, DM, WUP + (size_t)u * 64 * DM, DM, DM, MP, 64 * u, f, wavep, lanep);
            REP_BAR(8); }
            SEAM(P + 8);
        }
        if (IN(P + 9)) { REPS(9) { const Args& a = fresh_args(); PH_IDS phase_e2(a, l, vcup, G, tidp); REP_BAR(9); } SEAM(P + 9); }
        if (IN(P + 10)) { REPS(10) {
            const Args& a = fresh_args(); PH_IDS
            const bf16* HACT = WSP(bf16, WS_HACT); const bf16* WDOWN = WLP(WL_WDOWN);
            RowSrc x1; x1.p = WSP(float, WS_X1F); x1.s = WSP(float, WS_X1F) + (size_t)MP * DM;
            const FRes f{x1, WSP(float, WS_U)};
            { pg8::Gemm g{HACT, WDOWN, MP, DM, DFF, DFF, DFF, 1 << 30, 0}; pg8::StaticOrder S; S.init(MP, DM, G, bx);
              Epi4<FRes> E{f}; pg8::gemm_phase<Epi4<FRes>, pg8::StaticOrder, true, true>(lds, g, S, E, tidp); }
            __syncthreads();
            for (int r5_ = 0; r5_ < (((REP_MASK >> 18) & 1) ? 2 : 1); ++r5_)
            for (int u = vcup; u < 128; u += G) skinny_unit<1>(lds, HACT + (size_t)MP * DFF, DFF, WDOWN + (size_t)u * 16 * DFF, DFF, DFF, MP, 16 * u, f, wavep, lanep);
            REP_BAR(10); }
            SEAM(P + 10);
        }
        if (IN(P + 11)) { REPS(11) {
            const Args& a = fresh_args(); PH_IDS
            if (l == DEPTH - 1) phase_ln(WSP(float, WS_U), a.in[24] + (size_t)l * DM, a.in[25] + (size_t)l * DM, a.out + O_YP, nullptr, gwp, NGW, lanep);
            else phase_ln(WSP(float, WS_U), a.in[24] + (size_t)l * DM, a.in[25] + (size_t)l * DM, WSP(float, WS_XF), WSP(bf16, WS_XB), gwp, NGW, lanep);
            REP_BAR(11); }
            if (l != DEPTH - 1) SEAM(P + 11);
        }
    }
#undef WSP
#undef WLP
#undef IN
#undef SEAM
}

extern "C" void kernel_launch(void* const* d_in, const int* in_sizes, int n_in, void* d_out, int out_size, void* d_ws, size_t ws_size, hipStream_t stream) {
    static int grid = 0;
    if (grid == 0) {
        if (n_in != 26 || (size_t)out_size != O_END || ws_size < WS_END) { fprintf(stderr, "kernel_launch: unexpected n_in %d / out_size %d / ws %zu (want 26 / %zu / >= %zu)\n", n_in, out_size, ws_size, (size_t)O_END, (size_t)WS_END); grid = -1; return; }
        int dev = 0, cus = 0, per_cu = 0;
        if (hipGetDevice(&dev) != hipSuccess || hipDeviceGetAttribute(&cus, hipDeviceAttributeMultiprocessorCount, dev) != hipSuccess) { grid = -1; return; }
        if (hipFuncSetAttribute((const void*)mega_fwd, hipFuncAttributeMaxDynamicSharedMemorySize, LDS_BYTES) != hipSuccess) { fprintf(stderr, "kernel_launch: hipFuncSetAttribute failed\n"); grid = -1; return; }
        if (hipOccupancyMaxActiveBlocksPerMultiprocessor(&per_cu, (const void*)mega_fwd, NWAVES * 64, LDS_BYTES) != hipSuccess || per_cu < 1) { fprintf(stderr, "kernel_launch: occupancy query says %d blocks per CU\n", per_cu); (void)hipGetLastError(); grid = -1; return; }
        grid = cus;
    }
    if (grid < 0) return;
    if (hipMemsetAsync((char*)d_ws + WS_CTL, 0, CTL_ZERO_BYTES, stream) != hipSuccess) return;
    Args a{};
    for (int i = 0; i < 26; ++i) a.in[i] = (const float*)d_in[i];
    a.out = (float*)d_out; a.ws = (unsigned char*)d_ws;
#if MK_PER_PHASE
    for (int p = 0; p < N_PHASES; ++p) { a.ph_lo = p; a.ph_hi = p + 1; hipLaunchKernelGGL(mega_fwd, dim3(grid), dim3(NWAVES * 64), LDS_BYTES, stream, a); }
#else
    a.ph_lo = 0; a.ph_hi = N_PHASES;
    hipLaunchKernelGGL(mega_fwd, dim3(grid), dim3(NWAVES * 64), LDS_BYTES, stream, a);
#endif
}
```

```cpp
#include <hip/hip_runtime.h>
#include <cstdio>
#include <cstdint>
namespace pg8 {
#define PG8_LAS __attribute__((address_space(3)))
typedef unsigned short bf16_t;
typedef short bf16x8 __attribute__((ext_vector_type(8)));
typedef float f32x4 __attribute__((ext_vector_type(4)));
typedef unsigned u32x4 __attribute__((ext_vector_type(4)));
constexpr int BM = 256, BK = 64, HALF = 128, HTB = HALF * BK * 2  , STAGE_BYTES = 8 * HTB, NXCD = 8, WGM = 8;

__host__ __device__ __forceinline__ int lds_byte(int r, int c) { const int st = (r >> 4) * 2 + (c >> 5), rr = r & 15, cc = c & 31, ob = rr * 64 + cc * 2; return st * 1024 + (ob ^ (((ob >> 9) & 1) << 5)); }
__host__ __device__ __forceinline__ void stage_rc(int b, int& R, int& C) { const int st = b / 1024, sb = b % 1024, swz = sb ^ (((sb >> 9) & 1) << 5); R = (st >> 1) * 16 + swz / 64; C = (st & 1) * 32 + (swz % 64) / 2; }
__host__ __device__ __forceinline__ int perm32(int rho) { const int n = rho >> 4, i = rho & 15; return 8 * (i >> 2) + 4 * n + (i & 3); }

struct Unit { int pm, pn; };
struct Gemm { const bf16_t* A; const bf16_t* Bt; int M, N, K, lda, ldb, agdiv, agstride; };

struct StaticOrder {
    int nM, nN, nwg, G, c;
    __host__ __device__ __forceinline__ void init(int M, int N, int G_, int c_) { nM = M / BM; nN = N / BM; nwg = nM * nN; G = G_; c = c_; }
    __host__ __device__ __forceinline__ bool next(int i, Unit& u) const {
        const long L = (long)i * G + c; if (L >= nwg) return false;
        int wgid = (int)L; { const int q = nwg / NXCD, r = nwg % NXCD, xcd = wgid % NXCD, off = wgid / NXCD; wgid = (xcd < r ? xcd * (q + 1) : r * (q + 1) + (xcd - r) * q) + off; }
        const int nig = WGM * nN, gid = wgid / nig, fm = gid * WGM, gsz = (nM - fm) < WGM ? (nM - fm) : WGM;
        u.pm = fm + ((wgid % nig) % gsz); u.pn = (wgid % nig) / gsz; return true;
    }
    __device__ __forceinline__ void a_ready(const Unit&) const {}
    __device__ __forceinline__ void done(const Unit&) const {}
};

__device__ __forceinline__ unsigned cvt_pk_bf16(float lo, float hi) { unsigned r; asm volatile("v_cvt_pk_bf16_f32 %0, %1, %2" : "=v"(r) : "v"(lo), "v"(hi)); return r; }
typedef float f32x2 __attribute__((ext_vector_type(2)));
__device__ __forceinline__ f32x2 gelu_pk(f32x2 v) {
    const f32x2 av = __builtin_elementwise_abs(v), d = av * 0.2316418882f + 1.0f;
    f32x2 t; t.x = __builtin_amdgcn_rcpf(d.x); t.y = __builtin_amdgcn_rcpf(d.y);
    f32x2 q = t * 0.5307027145f + (-0.7265760135f); q = q * t + 0.7107068705f; q = q * t + (-0.142248368f); q = q * t + 0.127414796f; q = q * t;
    const f32x2 s = (v * v) * (-0.72134752044f);
    f32x2 e; e.x = __builtin_amdgcn_exp2f(s.x); e.y = __builtin_amdgcn_exp2f(s.y);
    const f32x2 m = v * (q * e), r = v - m;
    f32x2 o; o.x = v.x < 0.f ? m.x : r.x; o.y = v.y < 0.f ? m.y : r.y; return o;
}

template <int ACT  > struct EpiBf16 {
    static constexpr bool PERM = true, AFTER_DRAIN = false, KSEG = false; static_assert(ACT == 0 || ACT == 1, "EpiBf16: ACT is 0 (none) or 1 (gelu_pk)");
    bf16_t* O; int ldc; const float* bias; int split_cols; size_t split_stride; float scale0;
    __device__ __forceinline__ void operator()(const f32x4 (&acc)[2][2][4][2], const Unit& u, int wr, int wc, int fr, int fq) const {
        const int row0 = u.pm * BM + wr * 64 + fr; int colt = u.pn * BM; bf16_t* base = O;
        float sc = 1.f; if (split_cols) { const int t = colt / split_cols; base += (size_t)t * split_stride; colt -= t * split_cols; if (t == 0) sc = scale0; }
        const int col0 = colt + wc * 32 + 8 * fq, bcol0 = u.pn * BM + wc * 32 + 8 * fq;
        f32x4 bv[2][2];
#pragma unroll
        for (int bj = 0; bj < 2; ++bj)
#pragma unroll
            for (int n = 0; n < 2; ++n) bv[bj][n] = bias ? *(const f32x4*)(bias + bcol0 + bj * HALF + 4 * n) : (f32x4){0.f, 0.f, 0.f, 0.f};
#pragma unroll
        for (int ai = 0; ai < 2; ++ai)
#pragma unroll
            for (int m = 0; m < 4; ++m) { bf16_t* rowp = base + (size_t)(row0 + ai * HALF + m * 16) * ldc + col0;
#pragma unroll
                for (int bj = 0; bj < 2; ++bj) { f32x4 v0 = acc[ai][bj][m][0] + bv[bj][0], v1 = acc[ai][bj][m][1] + bv[bj][1];
                    if (ACT == 1) { f32x2 a = gelu_pk((f32x2){v0[0], v0[1]}), b = gelu_pk((f32x2){v0[2], v0[3]}), c = gelu_pk((f32x2){v1[0], v1[1]}), d = gelu_pk((f32x2){v1[2], v1[3]});
                        v0 = (f32x4){a.x, a.y, b.x, b.y}; v1 = (f32x4){c.x, c.y, d.x, d.y}; }
                    v0 = v0 * sc; v1 = v1 * sc; u32x4 w; w.x = cvt_pk_bf16(v0[0], v0[1]); w.y = cvt_pk_bf16(v0[2], v0[3]); w.z = cvt_pk_bf16(v1[0], v1[1]); w.w = cvt_pk_bf16(v1[2], v1[3]);
                    *(u32x4*)(rowp + bj * HALF) = w; } }
    }
};

template <class Epi, class Sched, bool ALIGN_EPI = false, bool SP2 = false>
__device__ __forceinline__ void gemm_phase(PG8_LAS unsigned char* lds, const Gemm g, const Sched& S, const Epi& E, const int tid) {
    const int wid = __builtin_amdgcn_readfirstlane(tid >> 6), lane = tid & 63, wr = wid >> 2, wc = wid & 3, fr = lane & 15, fq = lane >> 4;
    const int K = g.K, nt = K / BK;
    unsigned voffA[2], voffB[2];
#pragma unroll
    for (int i = 0; i < 2; ++i) { int R, C; stage_rc(tid * 16 + i * 8192, R, C); const int Rb = Epi::PERM ? ((R & ~31) + perm32(R & 31)) : R;
        voffA[i] = (unsigned)(R * g.lda + C) * 2u; voffB[i] = (unsigned)(Rb * g.ldb + C) * 2u; }
    const size_t kstep = (size_t)(BK * 2);
    const size_t hstepA = (size_t)HALF * g.lda * 2, hstepB = (size_t)HALF * g.ldb * 2;
    const size_t tstepA = 2 * hstepA, tstepB = 2 * hstepB;
    const unsigned ldsw = (unsigned)wid * 1024u;
    const int aoff = lds_byte(wr * 64 + fr, fq * 8), boff = lds_byte(wc * 32 + fr, fq * 8);
#define PG8_SA(b, h) (((b) * 2 + (h)) * HTB)
#define PG8_SB(b, h) ((4 + (b) * 2 + (h)) * HTB)
#define PG8_STAGE(bufoff, gbase, voff) do { _Pragma("unroll") for (int _i = 0; _i < 2; ++_i) \
        __builtin_amdgcn_global_load_lds((const unsigned*)((const char*)(gbase) + (voff)[_i]), (PG8_LAS unsigned*)(lds + (bufoff) + ldsw + _i * 8192), 16, 0, 0); } while (0)
#define PG8_LDA(dst, b, h) do { _Pragma("unroll") for (int m = 0; m < 4; ++m) _Pragma("unroll") for (int k = 0; k < 2; ++k) dst[m][k] = *(const PG8_LAS bf16x8*)(lds + PG8_SA(b, h) + aoff + m * 2048 + k * 1024); } while (0)
#define PG8_LDB(dst, b, h) do { _Pragma("unroll") for (int n = 0; n < 2; ++n) _Pragma("unroll") for (int k = 0; k < 2; ++k) dst[n][k] = *(const PG8_LAS bf16x8*)(lds + PG8_SB(b, h) + boff + n * 2048 + k * 1024); } while (0)
#define PG8_MMA(ai, bj, At, Bt) do { __builtin_amdgcn_s_setprio(1); _Pragma("unroll") for (int m = 0; m < 4; ++m) _Pragma("unroll") for (int n = 0; n < 2; ++n) _Pragma("unroll") for (int k = 0; k < 2; ++k) \
        acc[ai][bj][m][n] = __builtin_amdgcn_mfma_f32_16x16x32_bf16(Bt[n][k], At[m][k], acc[ai][bj][m][n], 0, 0, 0); __builtin_amdgcn_s_setprio(0); } while (0)
#define PG8_WAIT_V(n) asm volatile("s_waitcnt vmcnt(" #n ")" ::: "memory")
#define PG8_WAIT_L(n) asm volatile("s_waitcnt lgkmcnt(" #n ")" ::: "memory")
#define PG8_BAR __builtin_amdgcn_s_barrier()
#define PG8_SCHED __builtin_amdgcn_sched_barrier(0)
    Unit cur, nxt; int ui = 0;
    if (!S.next(0, cur)) return;
    f32x4 acc[2][2][4][2];
#pragma unroll
    for (int a = 0; a < 2; ++a)
#pragma unroll
        for (int b = 0; b < 2; ++b)
#pragma unroll
            for (int m = 0; m < 4; ++m)
#pragma unroll
                for (int n = 0; n < 2; ++n) acc[a][b][m][n] = (f32x4){0.f, 0.f, 0.f, 0.f};
    bf16x8 At[4][2], B0[2][2], B1[2][2];
    const char* cA = (const char*)g.A + (size_t)cur.pm * tstepA + (size_t)((cur.pn / g.agdiv) * g.agstride) * 2; const char* cB = (const char*)g.Bt + (size_t)cur.pn * tstepB;
    S.a_ready(cur);
    if constexpr (SP2) {
        PG8_STAGE(PG8_SB(0, 0), cB, voffB); PG8_STAGE(PG8_SB(0, 1), cB + hstepB, voffB); PG8_STAGE(PG8_SA(0, 0), cA, voffA); PG8_STAGE(PG8_SA(0, 1), cA + hstepA, voffA);
        if (wr == 1) PG8_BAR;
        PG8_WAIT_V(2); PG8_BAR;
        PG8_STAGE(PG8_SB(1, 0), cB + kstep, voffB); PG8_STAGE(PG8_SA(1, 0), cA + kstep, voffA); PG8_STAGE(PG8_SB(1, 1), cB + hstepB + kstep, voffB);
        PG8_WAIT_V(6); PG8_BAR;
    } else {
        PG8_STAGE(PG8_SB(0, 0), cB, voffB); PG8_STAGE(PG8_SA(0, 0), cA, voffA); PG8_STAGE(PG8_SB(0, 1), cB + hstepB, voffB); PG8_STAGE(PG8_SA(0, 1), cA + hstepA, voffA);
        if (wr == 1) PG8_BAR;
        PG8_WAIT_V(4); PG8_BAR;
        PG8_STAGE(PG8_SB(1, 0), cB + kstep, voffB); PG8_STAGE(PG8_SA(1, 0), cA + kstep, voffA); PG8_STAGE(PG8_SB(1, 1), cB + hstepB + kstep, voffB);
        PG8_WAIT_V(6); PG8_BAR;
    }
    for (;;) {
        const bool has_next = S.next(ui + 1, nxt);
        const char* nA = has_next ? (const char*)g.A + (size_t)nxt.pm * tstepA + (size_t)((nxt.pn / g.agdiv) * g.agstride) * 2 : cA; const char* nB = has_next ? (const char*)g.Bt + (size_t)nxt.pn * tstepB : cB;
        for (int t = 0; t < nt; t += 2) {
            const bool last = (t == nt - 2);
            const char* a1 = cA + (size_t)(t + 1) * kstep;
            const char* a2 = last ? nA : cA + (size_t)(t + 2) * kstep; const char* b2 = last ? nB : cB + (size_t)(t + 2) * kstep;
            const char* a3 = a2 + kstep; const char* b3 = b2 + kstep;
            if (last && has_next) S.a_ready(nxt);
            if constexpr (SP2) {
            PG8_LDB(B0, 0, 0); PG8_LDB(B1, 0, 1); PG8_SCHED; PG8_LDA(At, 0, 0); PG8_STAGE(PG8_SA(1, 1), a1 + hstepA, voffA);
            PG8_WAIT_V(8); PG8_WAIT_L(0); PG8_BAR; PG8_MMA(0, 0, At, B0); PG8_MMA(0, 1, At, B1); PG8_BAR; PG8_SCHED;
            PG8_LDA(At, 0, 1); PG8_STAGE(PG8_SB(0, 0), b2, voffB); PG8_STAGE(PG8_SB(0, 1), b2 + hstepB, voffB); PG8_STAGE(PG8_SA(0, 0), a2, voffA);
            PG8_WAIT_V(8); PG8_WAIT_L(0); PG8_BAR; PG8_MMA(1, 0, At, B0); PG8_MMA(1, 1, At, B1); PG8_BAR; PG8_SCHED;
            PG8_LDB(B0, 1, 0); PG8_LDB(B1, 1, 1); PG8_SCHED; PG8_LDA(At, 1, 0); PG8_STAGE(PG8_SA(0, 1), a2 + hstepA, voffA);
            PG8_WAIT_V(8); PG8_WAIT_L(0); PG8_BAR; PG8_MMA(0, 0, At, B0); PG8_MMA(0, 1, At, B1); PG8_BAR; PG8_SCHED;
            PG8_LDA(At, 1, 1); PG8_STAGE(PG8_SB(1, 0), b3, voffB); PG8_STAGE(PG8_SB(1, 1), b3 + hstepB, voffB); PG8_STAGE(PG8_SA(1, 0), a3, voffA);
            PG8_WAIT_V(8); PG8_WAIT_L(0); PG8_BAR; PG8_MMA(1, 0, At, B0); PG8_MMA(1, 1, At, B1); PG8_BAR; PG8_SCHED;
            } else {
            PG8_LDB(B0, 0, 0); PG8_SCHED; PG8_LDA(At, 0, 0); PG8_STAGE(PG8_SA(1, 1), a1 + hstepA, voffA);
            PG8_WAIT_L(8); PG8_BAR; PG8_WAIT_L(0); PG8_MMA(0, 0, At, B0); PG8_BAR; PG8_SCHED;
            PG8_LDB(B1, 0, 1); PG8_STAGE(PG8_SB(0, 0), b2, voffB);
            PG8_BAR; PG8_WAIT_L(0); PG8_MMA(0, 1, At, B1); PG8_BAR;
            PG8_LDA(At, 0, 1); PG8_STAGE(PG8_SA(0, 0), a2, voffA);
            PG8_BAR; PG8_WAIT_L(0); PG8_MMA(1, 0, At, B0); PG8_BAR; PG8_SCHED;
            PG8_STAGE(PG8_SB(0, 1), b2 + hstepB, voffB);
            PG8_WAIT_V(6); PG8_BAR; PG8_MMA(1, 1, At, B1); PG8_BAR;
            PG8_LDB(B0, 1, 0); PG8_SCHED; PG8_LDA(At, 1, 0); PG8_STAGE(PG8_SA(0, 1), a2 + hstepA, voffA);
            PG8_WAIT_L(8); PG8_BAR; PG8_WAIT_L(0); PG8_MMA(0, 0, At, B0); PG8_BAR; PG8_SCHED;
            PG8_LDB(B1, 1, 1); PG8_STAGE(PG8_SB(1, 0), b3, voffB);
            PG8_BAR; PG8_WAIT_L(0); PG8_MMA(0, 1, At, B1); PG8_BAR;
            PG8_LDA(At, 1, 1); PG8_STAGE(PG8_SA(1, 0), a3, voffA);
            PG8_BAR; PG8_WAIT_L(0); PG8_MMA(1, 0, At, B0); PG8_BAR; PG8_SCHED;
            PG8_STAGE(PG8_SB(1, 1), b3 + hstepB, voffB);
            PG8_WAIT_V(6); PG8_BAR; PG8_MMA(1, 1, At, B1); PG8_BAR;
            }
            if constexpr (Epi::KSEG) { if (((t + 2) & 7) == 0) E.kseg(acc, ((t + 2) >> 3) - 1, wr, fr, lds); }
        }
        if constexpr (ALIGN_EPI) { if (wr == 0) PG8_BAR; }
        if constexpr (!Epi::AFTER_DRAIN) { E(acc, cur, wr, wc, fr, fq); S.done(cur); }
        if (!has_next) break;
#pragma unroll
        for (int a = 0; a < 2; ++a)
#pragma unroll
            for (int b = 0; b < 2; ++b)
#pragma unroll
                for (int m = 0; m < 4; ++m)
#pragma unroll
                    for (int n = 0; n < 2; ++n) acc[a][b][m][n] = (f32x4){0.f, 0.f, 0.f, 0.f};
        cur = nxt; cA = nA; cB = nB; ++ui;
        if constexpr (ALIGN_EPI) { if (wr == 1) PG8_BAR; }
    }
    PG8_WAIT_V(0);
    if constexpr (!ALIGN_EPI) { if (wr == 0) PG8_BAR; }
    PG8_BAR;
    if constexpr (Epi::AFTER_DRAIN) { E.fused(acc, cur, wr, wc, fr, fq, lds, wid, lane); S.done(cur); }
#undef PG8_SA
#undef PG8_SB
#undef PG8_STAGE
#undef PG8_LDA
#undef PG8_LDB
#undef PG8_MMA
#undef PG8_WAIT_V
#undef PG8_WAIT_L
#undef PG8_BAR
#undef PG8_SCHED
}
}
#ifndef REP_MASK
#define REP_MASK 0
#endif
#ifndef TSEC
#define TSEC 0
#endif
#ifndef TWAVE
#define TWAVE 0
#endif
#define TMARK(sec_) do { if (TSEC != 0 && tsel_) { const unsigned long long now_ = __builtin_amdgcn_s_memrealtime(); if (TSEC == (sec_)) tacc_ += now_ - tlast_; tlast_ = now_; } } while (0)
constexpr int DM = 2048, NB = 4, SEQ = 2048, DEPTH = 2, NDEC = 128;
constexpr int MP = NB * SEQ;
constexpr int MT = MP + NDEC;
constexpr int DI = 4096, NH = 64, HD = 64, NG = 8, DS = 128, CD = 6144;
constexpr int DP = 2048, PB = 15, DFF = 5504, DIN = 16448, NPROJ = 16384, LDPJ = NPROJ + 64;
constexpr int OFF_Z = 0, OFF_XBC = 4096, OFF_DT = 10240, OFF_POOL = 10304, OFF_GATE = 12352;
constexpr int PC_Z = 0, PC_XBC = 4096, PC_POOL = 10240, PC_GATE = 12288;
constexpr float ALPHA = 1.4142135623730951f;
constexpr float LN_EPS = 1e-5f, RMS_EPS = 1e-5f;
constexpr int NWAVES = 8;

constexpr size_t O_YP = 0;
constexpr size_t O_YS = O_YP + (size_t)NB * SEQ * DM;
constexpr size_t O_SSM_P = O_YS + (size_t)NDEC * DM;
constexpr size_t O_CONV_P = O_SSM_P + (size_t)DEPTH * NB * NH * HD * DS;
constexpr size_t O_POOL_P = O_CONV_P + (size_t)DEPTH * NB * 3 * CD;
constexpr size_t O_FFN_P = O_POOL_P + (size_t)DEPTH * NB * PB * DP;
constexpr size_t O_SSM_S = O_FFN_P + (size_t)DEPTH * NB * 2 * 2 * DFF;
constexpr size_t O_CONV_S = O_SSM_S + (size_t)DEPTH * NDEC * NH * HD * DS;
constexpr size_t O_POOL_S = O_CONV_S + (size_t)DEPTH * NDEC * 3 * CD;
constexpr size_t O_FFN_S = O_POOL_S + (size_t)DEPTH * NDEC * PB * DP;
constexpr size_t O_END = O_FFN_S + (size_t)DEPTH * NDEC * 2 * 2 * DFF;

constexpr size_t MiB = 1u << 20;
constexpr size_t WS_CTL = 0, CTL_ZERO_BYTES = 1 * MiB;
constexpr size_t WL_WIN = 0, WL_WBR = 65 * MiB, WL_WPOOL = 81 * MiB, WL_WOUT = 83 * MiB, WL_WUP = 91 * MiB, WL_WDOWN = 134 * MiB, WL_SIZE = 156 * MiB;
constexpr size_t WS_W = 1 * MiB;
constexpr size_t WS_XB = WS_W + 2 * WL_SIZE;
constexpr size_t WS_XF = WS_XB + 33 * MiB;
constexpr size_t WS_PROJ = WS_XF + 65 * MiB;
constexpr size_t WS_DT = WS_PROJ + 262 * MiB;
constexpr size_t WS_V = WS_DT + 3 * MiB;
constexpr size_t WS_SSQ = WS_V + 65 * MiB;
constexpr size_t WS_YN = WS_SSQ + 3 * MiB;
constexpr size_t WS_POOLED = WS_YN + 65 * MiB;
constexpr size_t WS_YB = WS_POOLED + 33 * MiB;
constexpr size_t WS_MIX = WS_YB + 33 * MiB;
constexpr size_t WS_U = WS_MIX + 33 * MiB;
constexpr size_t WS_X1F = WS_U + 65 * MiB;
constexpr size_t WS_X1B = WS_X1F + 65 * MiB;
constexpr size_t WS_HPRE = WS_X1B + 33 * MiB;
constexpr size_t WS_HACT = WS_HPRE + 175 * MiB;
constexpr size_t WS_XC = WS_HACT + 88 * MiB;
constexpr size_t WS_DTS = WS_XC + 98 * MiB;
constexpr size_t WS_ACUM = WS_DTS + 3 * MiB;
constexpr size_t WS_WJ = WS_ACUM + 3 * MiB;
constexpr size_t WS_END = WS_WJ + 3 * MiB;
static_assert((size_t)MT * CD * 2 <= 98 * MiB, "act map 3");
static_assert((size_t)DIN * DM * 2 <= 65 * MiB && (size_t)2 * DFF * DM * 2 <= 43 * MiB && (size_t)DM * DFF * 2 <= 22 * MiB, "weight map");
static_assert((size_t)MT * LDPJ * 2 <= 262 * MiB && (size_t)MT * DI * 2 <= 65 * MiB && (size_t)MT * DM * 4 <= 65 * MiB && (size_t)MT * DM * 2 <= 33 * MiB, "act map");
static_assert((size_t)MT * 2 * DFF * 2 <= 175 * MiB && (size_t)MT * DFF * 2 <= 88 * MiB && (size_t)MT * 64 * 4 <= 3 * MiB, "act map 2");
constexpr int CW_BAR = 4096;

constexpr int LDS_BYTES = 156 * 1024;
constexpr int MISC_OFF = 152 * 1024;

#define GAS __attribute__((address_space(1)))
#define LAS __attribute__((address_space(3)))
typedef unsigned short bf16;
typedef unsigned v4u __attribute__((ext_vector_type(4)));
typedef unsigned v2u __attribute__((ext_vector_type(2)));
typedef float f32x4 __attribute__((ext_vector_type(4)));
typedef short bf16x8 __attribute__((ext_vector_type(8)));
typedef short bf16x4 __attribute__((ext_vector_type(4)));
#define LDS_WAIT() asm volatile("s_waitcnt lgkmcnt(0)" ::: "memory")
#define LDS_BARRIER() do { asm volatile("s_waitcnt lgkmcnt(0)" ::: "memory"); __builtin_amdgcn_s_barrier(); asm volatile("" ::: "memory"); } while (0)
#define VM_WAIT() asm volatile("s_waitcnt vmcnt(0)" ::: "memory")
__device__ __forceinline__ unsigned pk2(float lo, float hi) { return pg8::cvt_pk_bf16(lo, hi); }
__device__ __forceinline__ float bflo(unsigned u) { return __builtin_bit_cast(float, u << 16); }
__device__ __forceinline__ float bfhi(unsigned u) { return __builtin_bit_cast(float, u & 0xffff0000u); }
__device__ __forceinline__ float bf1(bf16 u) { return __builtin_bit_cast(float, (unsigned)u << 16); }
__device__ __forceinline__ f32x4 bf4(v2u u) { return (f32x4){bflo(u.x), bfhi(u.x), bflo(u.y), bfhi(u.y)}; }
__device__ __forceinline__ v2u pk4(f32x4 v) { v2u r; r.x = pk2(v[0], v[1]); r.y = pk2(v[2], v[3]); return r; }
__device__ __forceinline__ float siluf(float x) { return x * __builtin_amdgcn_rcpf(1.f + __expf(-x)); }
__device__ __forceinline__ float sigmf(float x) { return __builtin_amdgcn_rcpf(1.f + __expf(-x)); }
__device__ __forceinline__ float softplusf(float x) { return x > 20.f ? x : log1pf(expf(x)); }
__device__ __forceinline__ float wave_sum(float v) {
#pragma unroll
    for (int o = 1; o < 64; o <<= 1) v += __shfl_xor(v, o);
    return v;
}

#define XB_TMO      128
#define XB_XCNT(j)  (256  + 64 * (j))
#define XB_XSUB(j)  (1280 + 64 * (j))
#define XB_XGEN(j)  (2304 + 64 * (j))
#define XB_TOP      3328
#define XB_TOPGEN   3392
#define XCD_BAR_WORDS 3456
#define XB_SPIN_CAP (1u << 18)

__device__ __forceinline__ unsigned xb_ld(unsigned* p)              { return __hip_atomic_load(p, __ATOMIC_RELAXED, __HIP_MEMORY_SCOPE_AGENT); }
__device__ __forceinline__ unsigned xb_add(unsigned* p, unsigned v) { return __hip_atomic_fetch_add(p, v, __ATOMIC_RELAXED, __HIP_MEMORY_SCOPE_AGENT); }
__device__ __forceinline__ unsigned xb_xcc_id() { return (unsigned)__builtin_amdgcn_s_getreg((3 << 11) | 20) & 0xFu; }
#define XB_SPIN(cond, bar) do { unsigned _sp = 0; while (cond) { __builtin_amdgcn_s_sleep(1); \
    if ((++_sp & 255u) == 0u) { if (xb_ld(&(bar)[XB_TMO])) break; if (_sp > XB_SPIN_CAP) { atomicAdd(&(bar)[XB_TMO], 1u); break; } } } } while (0)

struct XcdBarrier {
    unsigned* bar; unsigned x;
    volatile LAS unsigned* st;
};

__device__ __forceinline__ XcdBarrier xcd_barrier_post(unsigned* bar, volatile LAS unsigned* st) {
    XcdBarrier b; b.bar = bar; b.x = xb_xcc_id(); b.st = st;
    if (threadIdx.x == 0) (void)xb_add(&bar[XB_XCNT(b.x)], 1u);
    return b;
}
__device__ __forceinline__ void xcd_barrier_complete(unsigned* bar, unsigned x, unsigned& nloc, unsigned& nx) {
    const unsigned G = gridDim.x * gridDim.y * gridDim.z;
    unsigned sum, cnt, mine, sp = 0u;
    for (;;) {
        sum = 0u; cnt = 0u; mine = 0u;
#pragma unroll
        for (unsigned j = 0; j < 16; ++j) { const unsigned c = xb_ld(&bar[XB_XCNT(j)]); sum += c; cnt += (c > 0u) ? 1u : 0u; mine = (j == x) ? c : mine; }
        if (sum == G) break;
        __builtin_amdgcn_s_sleep(1);
        if ((++sp & 255u) == 0u) { if (xb_ld(&bar[XB_TMO])) break; if (sp > XB_SPIN_CAP) { atomicAdd(&bar[XB_TMO], 1u); break; } }
    }
    nloc = mine > 0u ? mine : 1u; nx = cnt > 0u ? cnt : 1u;
}

__device__ __forceinline__ void xcd_barrier(const XcdBarrier& b) {
    asm volatile("s_waitcnt vmcnt(0)" ::: "memory");
    __syncthreads();
    if (threadIdx.x == 0) {
        unsigned* bar = b.bar;
        __builtin_amdgcn_s_waitcnt(0);
        unsigned nloc = b.st[0], nx = b.st[1];
        if (nloc == 0u) { xcd_barrier_complete(bar, b.x, nloc, nx); b.st[0] = nloc; b.st[1] = nx; }
        const unsigned old = xb_add(&bar[XB_XSUB(b.x)], 1u);
        const unsigned gen = old / nloc;
        if (old + 1u == (gen + 1u) * nloc) {
            __builtin_amdgcn_fence(__ATOMIC_RELEASE, "agent");
            asm volatile("s_waitcnt vmcnt(0)" ::: "memory");
            const unsigned og = xb_add(&bar[XB_TOP], 1u);
            const unsigned tg = og / nx;
            if (og + 1u == (tg + 1u) * nx) xb_add(&bar[XB_TOPGEN], 1u);
            else XB_SPIN(xb_ld(&bar[XB_TOPGEN]) == tg, bar);
            __builtin_amdgcn_fence(__ATOMIC_ACQUIRE, "agent");
            xb_add(&bar[XB_XGEN(b.x)], 1u);
            asm volatile("s_waitcnt vmcnt(0)" ::: "memory");
        } else {
            XB_SPIN(xb_ld(&bar[XB_XGEN(b.x)]) == gen, bar);
            __builtin_amdgcn_fence(__ATOMIC_ACQUIRE, "agent");
            asm volatile("s_waitcnt vmcnt(0)" ::: "memory");
        }
    }
    __syncthreads();
}


struct RowSrc { const float* p; const float* s; __device__ __forceinline__ const float* at(int row) const { return row < MP ? p + (size_t)row * DM : s + (size_t)(row - MP) * DM; } };

template <class F> struct Epi4 {
    static constexpr bool PERM = false, AFTER_DRAIN = false, KSEG = false; F f;
    __device__ __forceinline__ void operator()(const pg8::f32x4 (&acc)[2][2][4][2], const pg8::Unit& u, int wr, int wc, int fr, int fq) const {
        const int row0 = u.pm * 256 + wr * 64 + fr, col0 = u.pn * 256 + wc * 32 + 4 * fq;
#pragma unroll
        for (int ai = 0; ai < 2; ++ai)
#pragma unroll
            for (int m = 0; m < 4; ++m)
#pragma unroll
                for (int bj = 0; bj < 2; ++bj)
#pragma unroll
                    for (int n = 0; n < 2; ++n) f(row0 + ai * 128 + m * 16, col0 + bj * 128 + n * 16, acc[ai][bj][m][n]);
    }
};
constexpr int RT_OFF = 131072;
template <class F> struct Epi4K : Epi4<F> {
    static constexpr bool KSEG = true;
    __device__ __forceinline__ void kseg(pg8::f32x4 (&acc)[2][2][4][2], int seg, int wr, int fr, LAS unsigned char* lds) const {
        const LAS float* RT = (const LAS float*)(lds + RT_OFF);
#pragma unroll
        for (int ai = 0; ai < 2; ++ai)
#pragma unroll
            for (int m = 0; m < 4; ++m) { const float s = RT[(ai * 128 + wr * 64 + m * 16 + fr) * 8 + seg];
#pragma unroll
                for (int bj = 0; bj < 2; ++bj)
#pragma unroll
                    for (int n = 0; n < 2; ++n) acc[ai][bj][m][n] = acc[ai][bj][m][n] * s;
                asm volatile("" ::: "memory"); }
    }
};
struct FProj { bf16* PROJ; float* DT;
    __device__ __forceinline__ void operator()(int row, int col, f32x4 v) const {
        if (col < NPROJ) *(v2u*)(PROJ + (size_t)row * LDPJ + col) = pk4(v);
        else *(f32x4*)(DT + (size_t)row * 64 + (col - NPROJ)) = v; } };
struct FYb { const float* scale; bf16* YB;
    __device__ __forceinline__ void operator()(int row, int col, f32x4 v) const {
        const f32x4 s = *(const f32x4*)(scale + col); *(v2u*)(YB + (size_t)row * DM + col) = pk4(v * s); } };
struct FMix { const bf16* PROJ; const float* bg; const bf16* YB; bf16* MIX;
    __device__ __forceinline__ void operator()(int row, int col, f32x4 v) const {
        const f32x4 ga = bf4(*(const v2u*)(PROJ + (size_t)row * LDPJ + PC_GATE + col)) + *(const f32x4*)(bg + col);
        const f32x4 gb = bf4(*(const v2u*)(PROJ + (size_t)row * LDPJ + PC_GATE + DM + col)) + *(const f32x4*)(bg + DM + col);
        const f32x4 yb = bf4(*(const v2u*)(YB + (size_t)row * DM + col));
        f32x4 o;
#pragma unroll
        for (int e = 0; e < 4; ++e) o[e] = sigmf(ga[e]) * v[e] + sigmf(gb[e]) * yb[e];
        *(v2u*)(MIX + (size_t)row * DM + col) = pk4(o); } };
struct FRes { RowSrc x; float* U;
    __device__ __forceinline__ void operator()(int row, int col, f32x4 v) const {
        const f32x4 xr = *(const f32x4*)(x.at(row) + col); *(f32x4*)(U + (size_t)row * DM + col) = xr * ALPHA + v; } };
struct FBf { bf16* O; int ldc;
    __device__ __forceinline__ void operator()(int row, int col, f32x4 v) const { *(v2u*)(O + (size_t)row * ldc + col) = pk4(v); } };

template <int NT, class F, int SKU = (NT == 1 ? 4 : 2)>
__device__ __forceinline__ void skinny_unit(LAS unsigned char* lds, const bf16* A, int lda, const bf16* Bt, int ldb, int K, int row0, int col0, const F& f, int wave, int lane) {
    const int l15 = lane & 15, g4 = lane >> 4;
    f32x4 acc[8][NT];
#pragma unroll
    for (int rt = 0; rt < 8; ++rt)
#pragma unroll
        for (int ct = 0; ct < NT; ++ct) acc[rt][ct] = (f32x4){0.f, 0.f, 0.f, 0.f};
    const int nsteps = K / 32;
    const bf16* ap = A + (size_t)l15 * lda + 8 * g4;
    const bf16* bp = Bt + (size_t)l15 * ldb + 8 * g4;
#pragma unroll 1
    for (int s0 = wave; s0 < nsteps; s0 += 8 * SKU) {
        bf16x8 afu[SKU][8], bfu[SKU][NT];
#pragma unroll
        for (int u = 0; u < SKU; ++u) { const int s = (s0 + 8 * u < nsteps) ? s0 + 8 * u : s0;
#pragma unroll
            for (int rt = 0; rt < 8; ++rt) afu[u][rt] = *(const bf16x8*)(ap + (size_t)rt * 16 * lda + 32 * s);
#pragma unroll
            for (int ct = 0; ct < NT; ++ct) bfu[u][ct] = *(const bf16x8*)(bp + (size_t)ct * 16 * ldb + 32 * s); }
#pragma unroll
        for (int u = 0; u < SKU; ++u) { if (s0 + 8 * u < nsteps) {
#pragma unroll
            for (int rt = 0; rt < 8; ++rt)
#pragma unroll
                for (int ct = 0; ct < NT; ++ct) acc[rt][ct] = __builtin_amdgcn_mfma_f32_16x16x32_bf16(bfu[u][ct], afu[u][rt], acc[rt][ct], 0, 0, 0); } }
    }
#if 0
    for (int s = wave; s < nsteps; s += 8) {
        bf16x8 af[8], bfr[NT];
#pragma unroll
        for (int rt = 0; rt < 8; ++rt) af[rt] = *(const bf16x8*)(ap + (size_t)rt * 16 * lda + 32 * s);
#pragma unroll
        for (int ct = 0; ct < NT; ++ct) bfr[ct] = *(const bf16x8*)(bp + (size_t)ct * 16 * ldb + 32 * s);
#pragma unroll
        for (int rt = 0; rt < 8; ++rt)
#pragma unroll
            for (int ct = 0; ct < NT; ++ct) acc[rt][ct] = __builtin_amdgcn_mfma_f32_16x16x32_bf16(bfr[ct], af[rt], acc[rt][ct], 0, 0, 0);
    }
#endif
    constexpr int PITCH = 16 * NT * 4 + 16, SLOT = 128 * PITCH, NBATCH = (NT == 4) ? 2 : 1, WPB = 8 / NBATCH;
    f32x4 r[NT];
#pragma unroll
    for (int ct = 0; ct < NT; ++ct) r[ct] = (f32x4){0.f, 0.f, 0.f, 0.f};
#pragma unroll
    for (int batch = 0; batch < NBATCH; ++batch) {
        if (wave / WPB == batch) {
#pragma unroll
            for (int rt = 0; rt < 8; ++rt)
#pragma unroll
                for (int ct = 0; ct < NT; ++ct) *(LAS f32x4*)(lds + (wave % WPB) * SLOT + (16 * rt + l15) * PITCH + (16 * ct + 4 * g4) * 4) = acc[rt][ct];
        }
        __syncthreads();
#pragma unroll
        for (int slot = 0; slot < WPB; ++slot)
#pragma unroll
            for (int ct = 0; ct < NT; ++ct) r[ct] += *(const LAS f32x4*)(lds + slot * SLOT + (16 * wave + l15) * PITCH + (16 * ct + 4 * g4) * 4);
        __syncthreads();
    }
#pragma unroll
    for (int ct = 0; ct < NT; ++ct) f(row0 + 16 * wave + l15, col0 + 16 * ct + 4 * g4, r[ct]);
}

struct TJob { const float* src; const float* kscale; bf16* dst; int lds_, col0, K, drow0, k0, n0; };
__device__ __forceinline__ void tjob_load(const TJob& j, f32x4 (&v)[16], int lane) {
#pragma unroll
    for (int i = 0; i < 16; ++i) { const int kr = 4 * i + (lane >> 4); v[i] = *(const f32x4*)(j.src + (size_t)(j.k0 + kr) * j.lds_ + j.col0 + j.n0 + 4 * (lane & 15)); }
}
__device__ __forceinline__ void tjob_store(const TJob& j, f32x4 (&v)[16], LAS float* scr, int lane) {
    if (j.kscale) {
#pragma unroll
        for (int i = 0; i < 16; ++i) v[i] = v[i] * j.kscale[j.k0 + 4 * i + (lane >> 4)];
    }
#pragma unroll
    for (int i = 0; i < 16; ++i) { LAS float* d = scr + (4 * i + (lane >> 4)) * 65 + 4 * (lane & 15); d[0] = v[i][0]; d[1] = v[i][1]; d[2] = v[i][2]; d[3] = v[i][3]; }
    LDS_WAIT(); asm volatile("" ::: "memory");
    const int c = lane & 7;
#pragma unroll
    for (int jj = 0; jj < 8; ++jj) { const int n = (lane >> 3) + 8 * jj; const LAS float* s = scr + (8 * c) * 65 + n;
        v4u o; o.x = pk2(s[0 * 65], s[1 * 65]); o.y = pk2(s[2 * 65], s[3 * 65]); o.z = pk2(s[4 * 65], s[5 * 65]); o.w = pk2(s[6 * 65], s[7 * 65]);
        *(v4u*)(j.dst + (size_t)(j.drow0 + j.n0 + n) * j.K + j.k0 + 8 * c) = o; }
    LDS_WAIT(); asm volatile("" ::: "memory");
}

struct Args { const float* in[26]; float* out; unsigned char* ws; int ph_lo, ph_hi; };
__device__ __forceinline__ const Args& fresh_args() {
    auto p = __builtin_amdgcn_kernarg_segment_ptr();
    asm volatile("" : "+s"(p));
    return *(const Args*)p;
}

constexpr int I_INA = 32 * 160, I_INB = 32 * 1, I_INC = 32 * 96, I_BR = 64 * 32, I_PL = 8 * 8, I_OUT = 32 * 32, I_UP = 32 * 172, I_DN = 86 * 32;
constexpr int TJ_PER_LAYER = I_INA + I_INB + I_INC + I_BR + 4 * I_PL + I_OUT + I_UP + I_DN;
__device__ __forceinline__ TJob tjob_decode(const Args& a, int it) {
    const int l = it / TJ_PER_LAYER; int r = it % TJ_PER_LAYER;
    unsigned char* wl = a.ws + WS_W + (size_t)l * WL_SIZE;
    TJob j; j.kscale = nullptr; j.col0 = 0; j.drow0 = 0; int ntn;
    if (r < I_INA) { j.src = a.in[6] + (size_t)l * DM * DIN; j.lds_ = DIN; j.K = DM; j.dst = (bf16*)(wl + WL_WIN); ntn = 160; }
    else if ((r -= I_INA) < I_INB) { j.src = a.in[6] + (size_t)l * DM * DIN; j.lds_ = DIN; j.col0 = OFF_DT; j.K = DM; j.dst = (bf16*)(wl + WL_WIN); j.drow0 = NPROJ; ntn = 1; }
    else if ((r -= I_INB) < I_INC) { j.src = a.in[6] + (size_t)l * DM * DIN; j.lds_ = DIN; j.col0 = OFF_POOL; j.K = DM; j.dst = (bf16*)(wl + WL_WIN); j.drow0 = PC_POOL; ntn = 96; }
    else if ((r -= I_INC) < I_BR) { j.src = a.in[14] + (size_t)l * DI * DM; j.lds_ = DM; j.K = DI; j.dst = (bf16*)(wl + WL_WBR); j.kscale = a.in[13] + (size_t)l * DI; ntn = 32; }
    else if ((r -= I_BR) < 4 * I_PL) { const int g = r / I_PL; r %= I_PL; j.src = a.in[15] + ((size_t)l * 4 + g) * 512 * 512; j.lds_ = 512; j.K = 512; j.dst = (bf16*)(wl + WL_WPOOL); j.drow0 = g * 512; ntn = 8; }
    else if ((r -= 4 * I_PL) < I_OUT) { j.src = a.in[17] + (size_t)l * DM * DM; j.lds_ = DM; j.K = DM; j.dst = (bf16*)(wl + WL_WOUT); ntn = 32; }
    else if ((r -= I_OUT) < I_UP) { j.src = a.in[20] + (size_t)l * DM * 2 * DFF; j.lds_ = 2 * DFF; j.K = DM; j.dst = (bf16*)(wl + WL_WUP); ntn = 172; }
    else { r -= I_UP; j.src = a.in[23] + (size_t)l * DFF * DM; j.lds_ = DM; j.K = DFF; j.dst = (bf16*)(wl + WL_WDOWN); ntn = 32; }
    j.k0 = 64 * (r / ntn); j.n0 = 64 * (r % ntn);
    return j;
}

__device__ __forceinline__ void p0_prologue(const Args& a, LAS unsigned char* lds, int gw, int NGW, int gt, int NGT, int wave, int lane) {
    LAS float* scr = (LAS float*)(lds + wave * 16640);
    constexpr int NIT = 2 * TJ_PER_LAYER;
    if (gw < NIT) {
        TJob cur = tjob_decode(a, gw); f32x4 v[16]; tjob_load(cur, v, lane);
        for (int it = gw; it < NIT; it += NGW) {
            const int itn = (it + NGW < NIT) ? it + NGW : it;
            const TJob nxt = tjob_decode(a, itn); f32x4 vn[16]; tjob_load(nxt, vn, lane);
            tjob_store(cur, v, scr, lane);
            cur = nxt;
#pragma unroll
            for (int i = 0; i < 16; ++i) v[i] = vn[i];
        }
    }
    bf16* XB = (bf16*)(a.ws + WS_XB);
    for (int i = gt; i < MT * (DM / 8); i += NGT) {
        const int row = i / (DM / 8), c8 = (i % (DM / 8)) * 8;
        const float* src = (row < MP ? a.in[0] + (size_t)row * DM : a.in[1] + (size_t)(row - MP) * DM) + c8;
        const f32x4 v0 = *(const f32x4*)src, v1 = *(const f32x4*)(src + 4);
        v4u o; o.x = pk2(v0[0], v0[1]); o.y = pk2(v0[2], v0[3]); o.z = pk2(v1[0], v1[1]); o.w = pk2(v1[2], v1[3]);
        *(v4u*)(XB + (size_t)row * DM + c8) = o;
    }
}

__device__ __forceinline__ void ld8bf(const bf16* p, float (&v)[8]) { const v4u w = *(const v4u*)p; v[0] = bflo(w.x); v[1] = bfhi(w.x); v[2] = bflo(w.y); v[3] = bfhi(w.y); v[4] = bflo(w.z); v[5] = bfhi(w.z); v[6] = bflo(w.w); v[7] = bfhi(w.w); }
__device__ __forceinline__ void ld8f(const float* p, float (&v)[8]) { const f32x4 a0 = *(const f32x4*)p, a1 = *(const f32x4*)(p + 4); v[0] = a0[0]; v[1] = a0[1]; v[2] = a0[2]; v[3] = a0[3]; v[4] = a1[0]; v[5] = a1[1]; v[6] = a1[2]; v[7] = a1[3]; }
__device__ __forceinline__ void st8f(float* p, const float (&v)[8]) { *(f32x4*)p = (f32x4){v[0], v[1], v[2], v[3]}; *(f32x4*)(p + 4) = (f32x4){v[4], v[5], v[6], v[7]}; }
__device__ __forceinline__ void phase_a2(const Args& a, int l, int vcu, int G, int tid, int lane, int gw, int NGW, int gt, int NGT) {
    const bf16* PROJ = (const bf16*)(a.ws + WS_PROJ); bf16* XC = (bf16*)(a.ws + WS_XC);
    const float* DT = (const float*)(a.ws + WS_DT); float* DTS = (float*)(a.ws + WS_DTS); float* ACUM = (float*)(a.ws + WS_ACUM); float* WJ = (float*)(a.ws + WS_WJ);
    const float* cw = a.in[8] + (size_t)l * 4 * CD; const float* cb = a.in[9] + (size_t)l * CD;
    const float* stc = a.in[3] + (size_t)l * NDEC * 3 * CD;
    for (int r3_ = 0; r3_ < (((REP_MASK >> 15) & 1) ? 2 : 1); ++r3_)
    for (int ch = tid; ch < CD / 4; ch += 512) {
        const int c4 = 4 * ch;
        f32x4 w[4];
#pragma unroll
        for (int j = 0; j < 4; ++j) w[j] = *(const f32x4*)(cw + (size_t)j * CD + c4);
        const f32x4 bias = *(const f32x4*)(cb + c4);
        for (int r = vcu; r < MP / 32; r += G) {
            const int row0 = 32 * r, t0 = row0 & (SEQ - 1);
            v2u raw[35];
#pragma unroll
            for (int k = 0; k < 35; ++k) { const int rr = (t0 - 3 + k) >= 0 ? row0 - 3 + k : row0; raw[k] = *(const v2u*)(PROJ + (size_t)rr * LDPJ + PC_XBC + c4); }
            if (t0 == 0) { raw[0] = (v2u){0u, 0u}; raw[1] = (v2u){0u, 0u}; raw[2] = (v2u){0u, 0u}; }
#pragma unroll
            for (int e = 0; e < 32; ++e) { f32x4 y = bias + w[0] * bf4(raw[e]) + w[1] * bf4(raw[e + 1]) + w[2] * bf4(raw[e + 2]) + w[3] * bf4(raw[e + 3]);
#pragma unroll
                for (int q = 0; q < 4; ++q) y[q] = siluf(y[q]);
                *(v2u*)(XC + (size_t)(row0 + e) * CD + c4) = pk4(y); }
        }
        for (int s = vcu; s < NDEC; s += G) {
            f32x4 y = bias;
#pragma unroll
            for (int j = 0; j < 3; ++j) y += w[j] * *(const f32x4*)(stc + ((size_t)s * 3 + j) * CD + c4);
            y += w[3] * bf4(*(const v2u*)(PROJ + (size_t)(MP + s) * LDPJ + PC_XBC + c4));
#pragma unroll
            for (int q = 0; q < 4; ++q) y[q] = siluf(y[q]);
            *(v2u*)(XC + (size_t)(MP + s) * CD + c4) = pk4(y);
        }
    }
    for (int r4_ = 0; r4_ < (((REP_MASK >> 16) & 1) ? 2 : 1); ++r4_) {
    for (int task = gw; task < NB * (SEQ / 128) * NH; task += NGW) {
        const int h = task & 63; const size_t row0 = (size_t)(task >> 6) * 128;
        const float a_h = -expf(a.in[11][l * NH + h]), dtb = a.in[10][l * NH + h];
        const float d0 = softplusf(DT[(row0 + 2 * lane) * 64 + h] + dtb), d1 = softplusf(DT[(row0 + 2 * lane + 1) * 64 + h] + dtb);
        const float a0 = d0 * a_h, a1 = d1 * a_h; float s = a0 + a1;
#pragma unroll
        for (int o = 1; o < 64; o <<= 1) { const float t = __shfl_up(s, o); if (lane >= o) s += t; }
        const float aend = __shfl(s, 63), ac0 = s - a1, ac1 = s;
        DTS[(row0 + 2 * lane) * 64 + h] = d0; DTS[(row0 + 2 * lane + 1) * 64 + h] = d1;
        ACUM[(row0 + 2 * lane) * 64 + h] = ac0; ACUM[(row0 + 2 * lane + 1) * 64 + h] = ac1;
        WJ[(row0 + 2 * lane) * 64 + h] = d0 * __expf(aend - ac0); WJ[(row0 + 2 * lane + 1) * 64 + h] = d1 * __expf(aend - ac1);
    }
    for (int i = gt; i < NDEC * NH; i += NGT) { const size_t o = (size_t)MP * 64 + i; DTS[o] = softplusf(DT[o] + a.in[10][l * NH + (i & 63)]); }
    bf16* POOLED = (bf16*)(a.ws + WS_POOLED);
    const float* stp = a.in[4] + (size_t)l * NDEC * PB * DP;
    float* op = a.out + O_POOL_P + (size_t)l * NB * PB * DP; float* os = a.out + O_POOL_S + (size_t)l * NDEC * PB * DP;
    for (int i = gt; i < (MP / 8) * (DP / 8); i += NGT) {
        const int run = i >> 8, c8 = (i & 255) * 8, win = 2 << (c8 >> 9);
        const int row0 = 8 * run, t0 = row0 & (SEQ - 1);
        const bf16* pp = PROJ + (size_t)row0 * LDPJ + PC_POOL + c8;
        float sum[8], u[8], x[8];
#pragma unroll
        for (int e = 0; e < 8; ++e) sum[e] = 0.f;
#pragma unroll
        for (int k = 1; k < 16; ++k) { if (k < win) { const bool ok = k <= t0; ld8bf(pp - (size_t)(ok ? k : 0) * LDPJ, x);
#pragma unroll
            for (int e = 0; e < 8; ++e) sum[e] += ok ? x[e] : 0.f; } }
#pragma unroll
        for (int j = 0; j < 8; ++j) {
            const int t = t0 + j;
            ld8bf(pp + (size_t)j * LDPJ, u);
#pragma unroll
            for (int e = 0; e < 8; ++e) sum[e] += u[e];
            const int cnt = (t + 1 < win) ? t + 1 : win; const float inv = 1.f / (float)cnt;
            v4u o; o.x = pk2(sum[0] * inv - u[0], sum[1] * inv - u[1]); o.y = pk2(sum[2] * inv - u[2], sum[3] * inv - u[3]); o.z = pk2(sum[4] * inv - u[4], sum[5] * inv - u[5]); o.w = pk2(sum[6] * inv - u[6], sum[7] * inv - u[7]);
            *(v4u*)(POOLED + (size_t)(row0 + j) * DP + c8) = o;
            if (t >= SEQ - PB) st8f(op + ((size_t)(row0 >> 11) * PB + (t - (SEQ - PB))) * DP + c8, u);
            const bool ok = (t + 1 - win) >= 0; ld8bf(pp + ((ptrdiff_t)j + 1 - (ok ? win : 0)) * (ptrdiff_t)LDPJ, x);
#pragma unroll
            for (int e = 0; e < 8; ++e) sum[e] -= ok ? x[e] : 0.f;
        }
    }
    for (int i = gt; i < NDEC * (DP / 8); i += NGT) {
        const int s = i >> 8, c8 = (i & 255) * 8, win = 2 << (c8 >> 9), row = MP + s;
        float u[8], sum[8], x[8]; ld8bf(PROJ + (size_t)row * LDPJ + PC_POOL + c8, u);
#pragma unroll
        for (int e = 0; e < 8; ++e) sum[e] = u[e];
#pragma unroll
        for (int k = 1; k < 16; ++k) { ld8f(stp + ((size_t)s * PB + (PB - k)) * DP + c8, x); if (k < PB) st8f(os + ((size_t)s * PB + (PB - 1 - k)) * DP + c8, x);
            if (k < win) {
#pragma unroll
                for (int e = 0; e < 8; ++e) sum[e] += x[e]; } }
        st8f(os + ((size_t)s * PB + PB - 1) * DP + c8, u);
        const float inv = 1.f / (float)win;
        v4u o; o.x = pk2(sum[0] * inv - u[0], sum[1] * inv - u[1]); o.y = pk2(sum[2] * inv - u[2], sum[3] * inv - u[3]); o.z = pk2(sum[4] * inv - u[4], sum[5] * inv - u[5]); o.w = pk2(sum[6] * inv - u[6], sum[7] * inv - u[7]);
        *(v4u*)(POOLED + (size_t)row * DP + c8) = o;
    }
    float* ocp = a.out + O_CONV_P + (size_t)l * NB * 3 * CD; float* ocs = a.out + O_CONV_S + (size_t)l * NDEC * 3 * CD;
    for (int i = gt; i < (NB + NDEC) * 3 * (CD / 8); i += NGT) {
        const int c8 = (i % (CD / 8)) * 8, j = (i / (CD / 8)) % 3, q = i / (3 * (CD / 8));
        f32x4 v0, v1; float* o;
        if (q < NB) { const v4u w = *(const v4u*)(PROJ + (size_t)(q * SEQ + SEQ - 3 + j) * LDPJ + PC_XBC + c8); v0 = (f32x4){bflo(w.x), bfhi(w.x), bflo(w.y), bfhi(w.y)}; v1 = (f32x4){bflo(w.z), bfhi(w.z), bflo(w.w), bfhi(w.w)};
            o = ocp + ((size_t)q * 3 + j) * CD + c8; }
        else { const int s = q - NB; o = ocs + ((size_t)s * 3 + j) * CD + c8;
            if (j < 2) { const float* sp = stc + ((size_t)s * 3 + j + 1) * CD + c8; v0 = *(const f32x4*)sp; v1 = *(const f32x4*)(sp + 4); }
            else { const v4u w = *(const v4u*)(PROJ + (size_t)(MP + s) * LDPJ + PC_XBC + c8); v0 = (f32x4){bflo(w.x), bfhi(w.x), bflo(w.y), bfhi(w.y)}; v1 = (f32x4){bflo(w.z), bfhi(w.z), bflo(w.w), bfhi(w.w)}; } }
        *(f32x4*)o = v0; *(f32x4*)(o + 4) = v1;
    }
    }
}

constexpr int SP = 272, SPX = 144;
constexpr int L_CM = 0, L_BM = 128 * SP, L_XM = 2 * 128 * SP, L_XW = L_XM + 128 * SPX, L_SB = L_XW + 128 * SPX, L_DTV = L_SB + 64 * SP, L_ACUM = L_DTV + 512, L_ZM = L_ACUM + 512, L_SSD_END = L_ZM + 128 * SPX;
static_assert(L_SSD_END <= MISC_OFF, "SSD LDS map");
typedef short s16x4 __attribute__((ext_vector_type(4)));
__device__ __forceinline__ bf16x8 tr_pair(LAS unsigned char* p0, LAS unsigned char* p1) {
    const s16x4 lo = __builtin_amdgcn_ds_read_tr16_b64_v4i16((LAS s16x4*)p0), hi = __builtin_amdgcn_ds_read_tr16_b64_v4i16((LAS s16x4*)p1);
    return __builtin_shufflevector(lo, hi, 0, 1, 2, 3, 4, 5, 6, 7);
}

template <bool DEC>
__device__ __forceinline__ void ssd_prompt_unit(const Args& a, LAS unsigned char* lds, int l, int b, int h, int tid, int wave, int lane, int dq0, int dqs) {
    const bf16* PROJ = (const bf16*)(a.ws + WS_PROJ); const bf16* XC = (const bf16*)(a.ws + WS_XC);
    const float* DTS = (const float*)(a.ws + WS_DTS); const float* ACUM = (const float*)(a.ws + WS_ACUM); const float* WJ = (const float*)(a.ws + WS_WJ);
    bf16* V = (bf16*)(a.ws + WS_V); float* SSQ = (float*)(a.ws + WS_SSQ);
    const float Dh = a.in[12][l * NH + h];
    const int g = h >> 3, l15 = lane & 15, g4 = lane >> 4, w = wave;
    LAS float* dtv = (LAS float*)(lds + L_DTV); LAS float* acum = (LAS float*)(lds + L_ACUM);
    const bool tsel_ = (TSEC != 0) && blockIdx.x == 0 && wave == TWAVE; unsigned long long tacc_ = 0, tlast_ = (TSEC != 0) ? __builtin_amdgcn_s_memrealtime() : 0ull;
    v4u pc[4], pb[4], px[2], pzt[2]; float pwj[2], pda = 0.f;
#define SSD_PREFETCH(c_) do { const size_t r0_ = (size_t)b * SEQ + 128 * (c_); \
        _Pragma("unroll") for (int k = 0; k < 4; ++k) { const int q = tid + 512 * k, row = q >> 4, pcn = q & 15; \
            pc[k] = *(const v4u*)(XC + (r0_ + row) * CD + DI + NG * DS + g * DS + 8 * pcn); pb[k] = *(const v4u*)(XC + (r0_ + row) * CD + DI + g * DS + 8 * pcn); } \
        _Pragma("unroll") for (int k = 0; k < 2; ++k) { const int q = tid + 512 * k, row = q >> 3, pcn = q & 7; \
            px[k] = *(const v4u*)(XC + (r0_ + row) * CD + h * HD + 8 * pcn); pwj[k] = WJ[(r0_ + row) * 64 + h]; \
            pzt[k] = *(const v4u*)(PROJ + (r0_ + row) * LDPJ + PC_Z + h * HD + 8 * pcn); } \
        if (tid < 128) pda = DTS[(r0_ + tid) * 64 + h]; else if (tid < 256) pda = ACUM[(r0_ + tid - 128) * 64 + h]; \
        } while (0)
    f32x4 ds4[8]; f32x4 dB4 = {0.f, 0.f, 0.f, 0.f}, dC4 = {0.f, 0.f, 0.f, 0.f}; float dxc = 0.f, ddt = 0.f, ddA = 0.f, dz = 0.f, dyv = 0.f, dDh = 0.f;
    const int n4 = 4 * (lane & 31);
    unsigned short nxc = 0, nz = 0; v2u nB = {0u, 0u}, nC = {0u, 0u}; float ndt = 0.f, nal = 0.f, nDh = 0.f;
#define DEC_HDRN(k_) do { const int q_ = dq0 + (k_) * dqs, s_ = q_ >> 6, h_ = q_ & 63; const bf16* xrow_ = XC + (size_t)(MP + s_) * CD; \
        nxc = xrow_[h_ * HD + lane]; nB = *(const v2u*)(xrow_ + DI + (h_ >> 3) * DS + n4); nC = *(const v2u*)(xrow_ + DI + NG * DS + (h_ >> 3) * DS + n4); \
        ndt = DTS[(size_t)(MP + s_) * 64 + h_]; nal = a.in[11][l * NH + h_]; nDh = a.in[12][l * NH + h_]; \
        nz = PROJ[(size_t)(MP + s_) * LDPJ + PC_Z + h_ * HD + lane]; } while (0)
#define DEC_LOAD(c_) do { const int q_ = dq0 + ((c_) >> 2) * dqs; const float* sin_ = a.in[2] + ((size_t)l * NDEC * NH + q_) * HD * DS; \
        _Pragma("unroll") for (int i = 0; i < 8; ++i) ds4[i] = *(const f32x4*)(sin_ + (size_t)(((c_) & 3) * 8 + i + (lane & 32)) * DS + n4); } while (0)
    if (DEC) { DEC_HDRN(0); DEC_LOAD(0); }
    SSD_PREFETCH(0);
    f32x4 sacc[4];
#pragma unroll
    for (int pt = 0; pt < 4; ++pt) sacc[pt] = (f32x4){0.f, 0.f, 0.f, 0.f};
    for (int i = tid; i < 64 * SP / 4; i += 512) ((LAS unsigned*)(lds + L_SB))[i] = 0u;
    for (int c = 0; c < SEQ / 128; ++c) {
        const int tc = c * 128;
        TMARK(5);
#pragma unroll
        for (int k = 0; k < 4; ++k) { const int q = tid + 512 * k, row = q >> 4, pcn = q & 15; *(LAS v4u*)(lds + L_CM + row * SP + 16 * pcn) = pc[k]; *(LAS v4u*)(lds + L_BM + row * SP + 16 * pcn) = pb[k]; }
#pragma unroll
        for (int k = 0; k < 2; ++k) { const int q = tid + 512 * k, row = q >> 3, pcn = q & 7; const float wj = pwj[k]; const v4u x = px[k];
            *(LAS v4u*)(lds + L_XM + row * SPX + 16 * pcn) = x; *(LAS v4u*)(lds + L_ZM + row * SPX + 16 * pcn) = pzt[k];
            v4u xw; xw.x = pk2(bflo(x.x) * wj, bfhi(x.x) * wj); xw.y = pk2(bflo(x.y) * wj, bfhi(x.y) * wj); xw.z = pk2(bflo(x.z) * wj, bfhi(x.z) * wj); xw.w = pk2(bflo(x.w) * wj, bfhi(x.w) * wj);
            *(LAS v4u*)(lds + L_XW + row * SPX + 16 * pcn) = xw; }
        if (tid < 256) dtv[tid] = pda;
        if (DEC) {
            if ((c & 3) == 0) { dxc = bf1(nxc); dB4 = bf4(nB); dC4 = bf4(nC); ddt = ndt; ddA = __expf(ndt * -expf(nal)); dDh = nDh; dz = bf1(nz); dyv = 0.f; }
            const int q_ = dq0 + (c >> 2) * dqs; float* sout_ = a.out + O_SSM_S + ((size_t)l * NDEC * NH + q_) * HD * DS;
#pragma unroll
            for (int i = 0; i < 8; ++i) {
                const int it = (c & 3) * 8 + i, p = it + (lane & 32);
                f32x4 S4 = ds4[i];
                const float xp = __shfl(dxc, p);
                S4 = S4 * ddA + dB4 * (ddt * xp);
                float part = (dC4[0] * S4[0] + dC4[1] * S4[1]) + (dC4[2] * S4[2] + dC4[3] * S4[3]);
                *(f32x4*)(sout_ + (size_t)p * DS + n4) = S4;
#pragma unroll
                for (int o = 1; o < 32; o <<= 1) part += __shfl_xor(part, o);
                if ((lane & 31) == it) dyv = part;
            }
            if ((c & 3) == 3) {
                const int s_ = q_ >> 6, h_ = q_ & 63;
                const float v = (dyv + dDh * dxc) * siluf(dz);
                const float ss = wave_sum(v * v);
                if (lane == 0) SSQ[(size_t)(MP + s_) * 64 + h_] = ss;
                V[(size_t)(MP + s_) * DI + h_ * HD + lane] = (bf16)(pk2(v, 0.f) & 0xffffu);
            }
        }
        TMARK(1);
        LDS_BARRIER();
        TMARK(2);
        { const int cn = (c + 1 < SEQ / 128) ? c + 1 : c;
          SSD_PREFETCH(cn); if (DEC) { DEC_HDRN(cn >> 2); DEC_LOAD(cn); } }
        {
#define SB0() __builtin_amdgcn_sched_barrier(0)
            bf16x8 cf[4];
#pragma unroll
            for (int ks = 0; ks < 4; ++ks) cf[ks] = *(const LAS bf16x8*)(lds + L_CM + (16 * w + l15) * SP + (32 * ks + 8 * g4) * 2);
            const float ai = acum[16 * w + l15];
            bf16x8 q[2][4]; f32x4 ajq[2], djq[2];
#define LOADG(jt_, b_) do { _Pragma("unroll") for (int ks = 0; ks < 4; ++ks) q[b_][ks] = *(const LAS bf16x8*)(lds + L_BM + (16 * (jt_) + l15) * SP + (32 * ks + 8 * g4) * 2); \
                ajq[b_] = *(const LAS f32x4*)(acum + 16 * (jt_) + 4 * g4); djq[b_] = *(const LAS f32x4*)(dtv + 16 * (jt_) + 4 * g4); } while (0)
#define LOADS(pt_, b_) do { _Pragma("unroll") for (int ks = 0; ks < 4; ++ks) q[b_][ks] = *(const LAS bf16x8*)(lds + L_SB + (16 * (pt_) + l15) * SP + (32 * ks + 8 * g4) * 2); } while (0)
#define LOADX(s_, b_) do { _Pragma("unroll") for (int pt = 0; pt < 4; ++pt) { LAS unsigned char* xp_ = lds + L_XM + (32 * (s_) + 4 * g4 + (l15 >> 2)) * SPX + (16 * pt + 4 * (l15 & 3)) * 2; q[b_][pt] = tr_pair(xp_, xp_ + 16 * SPX); } } while (0)
            v2u gp[8];
            LOADG(0, 0);
#pragma unroll
            for (int jt = 0; jt < 8; ++jt) {
                if (jt < 7) LOADG(jt + 1, (jt + 1) & 1); else LOADS(0, 0);
                SB0();
                f32x4 acc = (f32x4){0.f, 0.f, 0.f, 0.f};
#pragma unroll
                for (int ks = 0; ks < 4; ++ks) acc = __builtin_amdgcn_mfma_f32_16x16x32_bf16(q[jt & 1][ks], cf[ks], acc, 0, 0, 0);
                const f32x4 aj = ajq[jt & 1], dj = djq[jt & 1];
                f32x4 m4;
#pragma unroll
                for (int e = 0; e < 4; ++e) { const bool ok = (16 * jt + 4 * g4 + e) <= (16 * w + l15); m4[e] = ok ? acc[e] * __expf(ai - aj[e]) * dj[e] : 0.f; }
                gp[jt] = pk4(m4);
                SB0();
            }
            f32x4 ya[4];
            const float eai = __expf(ai);
#pragma unroll
            for (int pt = 0; pt < 4; ++pt) {
                if (pt < 3) LOADS(pt + 1, (pt + 1) & 1); else LOADX(0, 0);
                SB0();
                f32x4 acc = (f32x4){0.f, 0.f, 0.f, 0.f};
#pragma unroll
                for (int ks = 0; ks < 4; ++ks) acc = __builtin_amdgcn_mfma_f32_16x16x32_bf16(q[pt & 1][ks], cf[ks], acc, 0, 0, 0);
                ya[pt] = acc * eai;
                SB0();
            }
#pragma unroll
            for (int s = 0; s < 4; ++s) {
                if (s < 3) LOADX(s + 1, (s + 1) & 1);
                SB0();
                bf16x8 mf; { const v2u lo = gp[2 * s], hi = gp[2 * s + 1]; v4u m; m.x = lo.x; m.y = lo.y; m.z = hi.x; m.w = hi.y; mf = __builtin_bit_cast(bf16x8, m); }
#pragma unroll
                for (int pt = 0; pt < 4; ++pt) ya[pt] = __builtin_amdgcn_mfma_f32_16x16x32_bf16(q[s & 1][pt], mf, ya[pt], 0, 0, 0);
                SB0();
            }
#undef LOADG
#undef LOADS
#undef LOADX
            const size_t r = (size_t)b * SEQ + tc + 16 * w + l15;
            float ss = 0.f;
#pragma unroll
            for (int pt = 0; pt < 4; ++pt) {
                const f32x4 z = bf4(*(const LAS v2u*)(lds + L_ZM + (16 * w + l15) * SPX + (16 * pt + 4 * g4) * 2));
                const f32x4 xv = bf4(*(const LAS v2u*)(lds + L_XM + (16 * w + l15) * SPX + (16 * pt + 4 * g4) * 2));
                f32x4 v;
#pragma unroll
                for (int e = 0; e < 4; ++e) { v[e] = (ya[pt][e] + Dh * xv[e]) * siluf(z[e]); ss += v[e] * v[e]; }
                *(v2u*)(V + r * DI + h * HD + 16 * pt + 4 * g4) = pk4(v);
            }
            ss += __shfl_xor(ss, 16); ss += __shfl_xor(ss, 32);
            if (g4 == 0) SSQ[r * 64 + h] = ss;
        }
        TMARK(3);
        LDS_BARRIER();
        TMARK(4);
        {
            const float dec = __expf(acum[127]);
#pragma unroll
            for (int pt = 0; pt < 4; ++pt) sacc[pt] = sacc[pt] * dec;
#pragma unroll
            for (int ks = 0; ks < 4; ++ks) {
                LAS unsigned char* bp = lds + L_BM + (32 * ks + 8 * g4 + (l15 >> 2)) * SP + (16 * w + 4 * (l15 & 3)) * 2;
                const bf16x8 bw = tr_pair(bp, bp + 4 * SP);
#pragma unroll
                for (int pt = 0; pt < 4; ++pt) { LAS unsigned char* xp = lds + L_XW + (32 * ks + 8 * g4 + (l15 >> 2)) * SPX + (16 * pt + 4 * (l15 & 3)) * 2;
                    sacc[pt] = __builtin_amdgcn_mfma_f32_16x16x32_bf16(bw, tr_pair(xp, xp + 4 * SPX), sacc[pt], 0, 0, 0); }
            }
#pragma unroll
            for (int pt = 0; pt < 4; ++pt) *(LAS v2u*)(lds + L_SB + (16 * pt + l15) * SP + (16 * w + 4 * g4) * 2) = pk4(sacc[pt]);
        }
        LDS_BARRIER();
    }
    if (TSEC != 0 && tsel_ && lane == 0) { volatile LAS unsigned* m_ = (volatile LAS unsigned*)(lds + MISC_OFF); m_[16] = m_[16] + (unsigned)tacc_; }
#undef SSD_PREFETCH
#undef DEC_HDRN
#undef DEC_LOAD
    float* so = a.out + O_SSM_P + (((size_t)l * NB + b) * NH + h) * HD * DS;
#pragma unroll
    for (int pt = 0; pt < 4; ++pt) *(f32x4*)(so + (size_t)(16 * pt + l15) * DS + 16 * w + 4 * g4) = sacc[pt];
}

__device__ __forceinline__ void ssd_decode_pair(const Args& a, int l, int s, int h, int lane) {
    const bf16* PROJ = (const bf16*)(a.ws + WS_PROJ); const bf16* XC = (const bf16*)(a.ws + WS_XC); const float* DTS = (const float*)(a.ws + WS_DTS);
    bf16* V = (bf16*)(a.ws + WS_V); float* SSQ = (float*)(a.ws + WS_SSQ);
    const float a_h = -expf(a.in[11][l * NH + h]), Dh = a.in[12][l * NH + h];
    const int g = h >> 3, r = MP + s, n4 = 4 * (lane & 31);
    const bf16* xrow = XC + (size_t)r * CD;
    const float xc = bf1(xrow[h * HD + lane]);
    const f32x4 B4 = bf4(*(const v2u*)(xrow + DI + g * DS + n4)), C4 = bf4(*(const v2u*)(xrow + DI + NG * DS + g * DS + n4));
    const float dt = DTS[(size_t)r * 64 + h], dA = __expf(dt * a_h);
    const float* sin = a.in[2] + (((size_t)l * NDEC + s) * NH + h) * HD * DS;
    float* sout = a.out + O_SSM_S + (((size_t)l * NDEC + s) * NH + h) * HD * DS;
    float yv = 0.f;
#pragma unroll 8
    for (int it = 0; it < 32; ++it) {
        const int p = it + (lane & 32);
        f32x4 S4 = *(const f32x4*)(sin + (size_t)p * DS + n4);
        const float xp = __shfl(xc, p);
        S4 = S4 * dA + B4 * (dt * xp);
        float part = (C4[0] * S4[0] + C4[1] * S4[1]) + (C4[2] * S4[2] + C4[3] * S4[3]);
        *(f32x4*)(sout + (size_t)p * DS + n4) = S4;
#pragma unroll
        for (int o = 1; o < 32; o <<= 1) part += __shfl_xor(part, o);
        if ((lane & 31) == it) yv = part;
    }
    const float z = bf1(PROJ[(size_t)r * LDPJ + PC_Z + h * HD + lane]);
    const float v = (yv + Dh * xc) * siluf(z);
    const float ss = wave_sum(v * v);
    if (lane == 0) SSQ[(size_t)r * 64 + h] = ss;
    V[(size_t)r * DI + h * HD + lane] = (bf16)(pk2(v, 0.f) & 0xffffu);
}

template <int NP>
__device__ __forceinline__ void ssd_decode_stream(const Args& a, int l, int q0, int qs, int lane) {
    const bf16* PROJ = (const bf16*)(a.ws + WS_PROJ); const bf16* XC = (const bf16*)(a.ws + WS_XC); const float* DTS = (const float*)(a.ws + WS_DTS);
    bf16* V = (bf16*)(a.ws + WS_V); float* SSQ = (float*)(a.ws + WS_SSQ);
    const int n4 = 4 * (lane & 31);
    f32x4 buf[2][16];
    unsigned short nxc = 0, nz = 0; v2u nB = {0u, 0u}, nC = {0u, 0u}; float ndt = 0.f, nal = 0.f, nDh = 0.f;
    f32x4 dB4 = {0.f, 0.f, 0.f, 0.f}, dC4 = {0.f, 0.f, 0.f, 0.f}; float dxc = 0.f, ddt = 0.f, ddA = 0.f, dz = 0.f, dyv = 0.f, dDh = 0.f;
#define DS_HDRN(k_) do { const int q_ = q0 + (k_) * qs, s_ = q_ >> 6, h_ = q_ & 63; const bf16* xrow_ = XC + (size_t)(MP + s_) * CD; \
        nxc = xrow_[h_ * HD + lane]; nB = *(const v2u*)(xrow_ + DI + (h_ >> 3) * DS + n4); nC = *(const v2u*)(xrow_ + DI + NG * DS + (h_ >> 3) * DS + n4); \
        ndt = DTS[(size_t)(MP + s_) * 64 + h_]; nal = a.in[11][l * NH + h_]; nDh = a.in[12][l * NH + h_]; nz = PROJ[(size_t)(MP + s_) * LDPJ + PC_Z + h_ * HD + lane]; } while (0)
#define DS_LOAD(bb_, b_, l32_) do { const int q_ = q0 + ((bb_) >> 1) * qs; const float* sin_ = a.in[2] + ((size_t)l * NDEC * NH + q_) * HD * DS; \
        _Pragma("unroll") for (int i = 0; i < 16; ++i) buf[b_][i] = *(const f32x4*)(sin_ + (size_t)(((bb_) & 1) * 16 + i + l32_) * DS + n4); } while (0)
#define DS_FOLD(bb_, b_) do { const int q_ = q0 + ((bb_) >> 1) * qs; float* sout_ = a.out + O_SSM_S + ((size_t)l * NDEC * NH + q_) * HD * DS; \
        _Pragma("unroll") for (int i = 0; i < 16; ++i) { const int it = ((bb_) & 1) * 16 + i, p = it + l32; \
            f32x4 S4 = buf[b_][i]; const float xp = __shfl(dxc, p); S4 = S4 * ddA + dB4 * (ddt * xp); \
            float part = (dC4[0] * S4[0] + dC4[1] * S4[1]) + (dC4[2] * S4[2] + dC4[3] * S4[3]); \
            *(f32x4*)(sout_ + (size_t)p * DS + n4) = S4; \
            _Pragma("unroll") for (int o = 1; o < 32; o <<= 1) part += __shfl_xor(part, o); \
            if ((lane & 31) == it) dyv = part; } } while (0)
    DS_HDRN(0); DS_LOAD(0, 0, (lane & 32));
    for (int k = 0; k < NP; ++k) {
        dxc = bf1(nxc); dB4 = bf4(nB); dC4 = bf4(nC); ddt = ndt; ddA = __expf(ndt * -expf(nal)); dDh = nDh; dz = bf1(nz); dyv = 0.f;
        int l32 = lane & 32; asm volatile("" : "+v"(l32));
        const int kn = (k + 1 < NP) ? k + 1 : k;
        DS_LOAD(2 * k + 1, 1, l32); DS_HDRN(kn);
        DS_FOLD(2 * k, 0);
        DS_LOAD(2 * kn, 0, l32);
        DS_FOLD(2 * k + 1, 1);
        const int q_ = q0 + k * qs, s_ = q_ >> 6, h_ = q_ & 63;
        const float v = (dyv + dDh * dxc) * siluf(dz);
        const float ss = wave_sum(v * v);
        if (lane == 0) SSQ[(size_t)(MP + s_) * 64 + h_] = ss;
        V[(size_t)(MP + s_) * DI + h_ * HD + lane] = (bf16)(pk2(v, 0.f) & 0xffffu);
    }
#undef DS_FOLD
#undef DS_HDRN
#undef DS_LOAD
}

__device__ __forceinline__ void phase_b2(const Args& a, int l, int gt, int NGT, int row_lo) {
    const bf16* V = (const bf16*)(a.ws + WS_V); const float* SSQ = (const float*)(a.ws + WS_SSQ); bf16* YN = (bf16*)(a.ws + WS_YN);
    for (int i = gt + row_lo * (DI / 8); i < MT * (DI / 8); i += NGT) {
        const int row = i >> 9, c8 = (i & 511) * 8, grp = c8 >> 9;
        const f32x4 q0 = *(const f32x4*)(SSQ + (size_t)row * 64 + grp * 8), q1 = *(const f32x4*)(SSQ + (size_t)row * 64 + grp * 8 + 4);
        const float rstd = rsqrtf(((q0[0] + q0[1]) + (q0[2] + q0[3]) + (q1[0] + q1[1]) + (q1[2] + q1[3])) * (1.f / 512.f) + RMS_EPS);
        const v4u u = *(const v4u*)(V + (size_t)row * DI + c8);
        v4u o; o.x = pk2(bflo(u.x) * rstd, bfhi(u.x) * rstd); o.y = pk2(bflo(u.y) * rstd, bfhi(u.y) * rstd); o.z = pk2(bflo(u.z) * rstd, bfhi(u.z) * rstd); o.w = pk2(bflo(u.w) * rstd, bfhi(u.w) * rstd);
        *(v4u*)(YN + (size_t)row * DI + c8) = o;
    }
}

__device__ __forceinline__ void phase_ln(const float* U, const float* g, const float* b, float* outf, bf16* outb, int gw, int NGW, int lane) {
    for (int row = gw; row < MT; row += NGW) {
        const float* ur = U + (size_t)row * DM + 4 * lane;
        f32x4 v[8]; float s = 0.f;
#pragma unroll
        for (int j = 0; j < 8; ++j) { v[j] = *(const f32x4*)(ur + 256 * j); s += (v[j][0] + v[j][1]) + (v[j][2] + v[j][3]); }
        const float mean = wave_sum(s) * (1.f / DM); float q = 0.f;
#pragma unroll
        for (int j = 0; j < 8; ++j) { v[j] = v[j] - mean; q += (v[j][0] * v[j][0] + v[j][1] * v[j][1]) + (v[j][2] * v[j][2] + v[j][3] * v[j][3]); }
        const float rstd = rsqrtf(wave_sum(q) * (1.f / DM) + LN_EPS);
#pragma unroll
        for (int j = 0; j < 8; ++j) {
            const f32x4 gg = *(const f32x4*)(g + 4 * lane + 256 * j), bb = *(const f32x4*)(b + 4 * lane + 256 * j);
            const f32x4 o = v[j] * rstd * gg + bb;
            *(f32x4*)(outf + (size_t)row * DM + 4 * lane + 256 * j) = o;
            if (outb) *(v2u*)(outb + (size_t)row * DM + 4 * lane + 256 * j) = pk4(o);
        }
    }
}

__device__ __forceinline__ void ffn_taps(const float* fw, const float* fb, int col, float (&w)[3][8], float (&bias)[8]) {
#pragma unroll
    for (int j = 0; j < 3; ++j) { const f32x4 a0 = *(const f32x4*)(fw + (size_t)j * 2 * DFF + col), a1 = *(const f32x4*)(fw + (size_t)j * 2 * DFF + col + 4);
        w[j][0] = a0[0]; w[j][1] = a0[1]; w[j][2] = a0[2]; w[j][3] = a0[3]; w[j][4] = a1[0]; w[j][5] = a1[1]; w[j][6] = a1[2]; w[j][7] = a1[3]; }
    const f32x4 b0 = *(const f32x4*)(fb + col), b1 = *(const f32x4*)(fb + col + 4);
    bias[0] = b0[0]; bias[1] = b0[1]; bias[2] = b0[2]; bias[3] = b0[3]; bias[4] = b1[0]; bias[5] = b1[1]; bias[6] = b1[2]; bias[7] = b1[3];
}
__device__ __forceinline__ void phase_e2(const Args& a, int l, int vcu, int G, int tid) {
    const bf16* HPRE = (const bf16*)(a.ws + WS_HPRE); bf16* HACT = (bf16*)(a.ws + WS_HACT);
    const float* fw = a.in[21] + (size_t)l * 3 * 2 * DFF; const float* fb = a.in[22] + (size_t)l * 2 * DFF;
    const float* stf = a.in[5] + (size_t)l * NDEC * 2 * 2 * DFF;
    float* ofp = a.out + O_FFN_P + (size_t)l * NB * 2 * 2 * DFF; float* ofs = a.out + O_FFN_S + (size_t)l * NDEC * 2 * 2 * DFF;
    for (int ch = tid; ch < DFF / 8; ch += 512) {
        const int c8 = ch * 8;
        float wg[3][8], bg_[8], wv[3][8], bv[8];
        ffn_taps(fw, fb, c8, wg, bg_); ffn_taps(fw, fb, DFF + c8, wv, bv);
        for (int rb = vcu; rb < MP / 32; rb += G) {
        const int r0 = 32 * rb, t0 = r0 & (SEQ - 1);
        float g2[8], g1[8], v2[8], v1[8];
#pragma unroll
        for (int e = 0; e < 8; ++e) { g2[e] = 0.f; g1[e] = 0.f; v2[e] = 0.f; v1[e] = 0.f; }
        if (t0 >= 2) { ld8bf(HPRE + (size_t)(r0 - 2) * 2 * DFF + c8, g2); ld8bf(HPRE + (size_t)(r0 - 2) * 2 * DFF + DFF + c8, v2);
                       ld8bf(HPRE + (size_t)(r0 - 1) * 2 * DFF + c8, g1); ld8bf(HPRE + (size_t)(r0 - 1) * 2 * DFF + DFF + c8, v1); }
        for (int i4 = 0; i4 < 32; i4 += 4) {
            v4u gq[4], vq[4];
#pragma unroll
            for (int q = 0; q < 4; ++q) { gq[q] = *(const v4u*)(HPRE + (size_t)(r0 + i4 + q) * 2 * DFF + c8); vq[q] = *(const v4u*)(HPRE + (size_t)(r0 + i4 + q) * 2 * DFF + DFF + c8); }
#pragma unroll
            for (int q = 0; q < 4; ++q) {
                const int r = r0 + i4 + q;
                const float g0[8] = {bflo(gq[q].x), bfhi(gq[q].x), bflo(gq[q].y), bfhi(gq[q].y), bflo(gq[q].z), bfhi(gq[q].z), bflo(gq[q].w), bfhi(gq[q].w)};
                const float v0[8] = {bflo(vq[q].x), bfhi(vq[q].x), bflo(vq[q].y), bfhi(vq[q].y), bflo(vq[q].z), bfhi(vq[q].z), bflo(vq[q].w), bfhi(vq[q].w)};
                float o[8];
#pragma unroll
                for (int e = 0; e < 8; ++e) { const float hg = bg_[e] + wg[0][e] * g2[e] + wg[1][e] * g1[e] + wg[2][e] * g0[e], hv = bv[e] + wv[0][e] * v2[e] + wv[1][e] * v1[e] + wv[2][e] * v0[e]; o[e] = siluf(hg) * hv; }
                v4u w; w.x = pk2(o[0], o[1]); w.y = pk2(o[2], o[3]); w.z = pk2(o[4], o[5]); w.w = pk2(o[6], o[7]);
                *(v4u*)(HACT + (size_t)r * DFF + c8) = w;
#pragma unroll
                for (int e = 0; e < 8; ++e) { g2[e] = g1[e]; g1[e] = g0[e]; v2[e] = v1[e]; v1[e] = v0[e]; }
            }
        }
        if (t0 + 32 == SEQ) { float* o2 = ofp + (size_t)(r0 >> 11) * 2 * 2 * DFF; st8f(o2 + c8, g2); st8f(o2 + DFF + c8, v2); st8f(o2 + 2 * DFF + c8, g1); st8f(o2 + 2 * DFF + DFF + c8, v1); }
        }
        for (int s = vcu; s < NDEC; s += G) {
            const int r = MP + s;
            float g2[8], g1[8], v2[8], v1[8];
            const float* sp = stf + (size_t)s * 2 * 2 * DFF;
            ld8f(sp + c8, g2); ld8f(sp + DFF + c8, v2); ld8f(sp + 2 * DFF + c8, g1); ld8f(sp + 2 * DFF + DFF + c8, v1);
            float g0[8], v0[8]; ld8bf(HPRE + (size_t)r * 2 * DFF + c8, g0); ld8bf(HPRE + (size_t)r * 2 * DFF + DFF + c8, v0);
            float o[8];
#pragma unroll
            for (int e = 0; e < 8; ++e) { const float hg = bg_[e] + wg[0][e] * g2[e] + wg[1][e] * g1[e] + wg[2][e] * g0[e], hv = bv[e] + wv[0][e] * v2[e] + wv[1][e] * v1[e] + wv[2][e] * v0[e]; o[e] = siluf(hg) * hv; }
            v4u w; w.x = pk2(o[0], o[1]); w.y = pk2(o[2], o[3]); w.z = pk2(o[4], o[5]); w.w = pk2(o[6], o[7]);
            *(v4u*)(HACT + (size_t)r * DFF + c8) = w;
            float* o2 = ofs + (size_t)s * 2 * 2 * DFF; st8f(o2 + c8, g1); st8f(o2 + DFF + c8, v1); st8f(o2 + 2 * DFF + c8, g0); st8f(o2 + 2 * DFF + DFF + c8, v0);
        }
    }
}

constexpr int PH_PER_LAYER = 12, N_PHASES = 1 + DEPTH * PH_PER_LAYER;
#ifndef MK_PER_PHASE
#define MK_PER_PHASE 0
#endif

__global__ void __launch_bounds__(NWAVES * 64, 2) mega_fwd(Args args) {
    extern __shared__ __attribute__((aligned(16))) unsigned char lds_raw[];
    LAS unsigned char* lds = (LAS unsigned char*)lds_raw;
    volatile LAS unsigned* MISC = (volatile LAS unsigned*)(lds + MISC_OFF);
    const int tid = threadIdx.x, lane = tid & 63, wave = __builtin_amdgcn_readfirstlane(tid >> 6);
    const int G = gridDim.x, bx = blockIdx.x, vcu = (G % 8 == 0) ? (bx % 8) * (G / 8) + bx / 8 : bx;
    const int gw = vcu * NWAVES + wave, NGW = G * NWAVES, gt = vcu * 512 + tid, NGT = G * 512;
    for (int u = tid; u < (LDS_BYTES - MISC_OFF) / 4; u += NWAVES * 64) ((LAS unsigned*)(lds + MISC_OFF))[u] = 0u;
    __syncthreads();
    unsigned* ctl = (unsigned*)(args.ws + WS_CTL);
    XcdBarrier bar; bar.bar = ctl + CW_BAR; bar.x = 0; bar.st = nullptr;
    if (!MK_PER_PHASE) bar = xcd_barrier_post(ctl + CW_BAR, MISC + 8);
    const int lo = args.ph_lo, hi = args.ph_hi;
#define IN(k) (lo <= (k) && (k) < hi)
#define REPS(k) for (int rep_ = 0; rep_ < (((REP_MASK >> (k)) & 1) ? 2 : 1); ++rep_)
#define REP_BAR(k) do { if (((REP_MASK >> (k)) & 1) && rep_ == 0 && !MK_PER_PHASE) xcd_barrier(bar); } while (0)
#define SEAM(k) do { if (!MK_PER_PHASE && IN((k) + 1)) xcd_barrier(bar); } while (0)

#define PH_IDS int wavep = wave; asm volatile("" : "+s"(wavep)); int vcup = vcu; asm volatile("" : "+s"(vcup)); int lanep = (int)__builtin_amdgcn_mbcnt_hi(~0u, __builtin_amdgcn_mbcnt_lo(~0u, 0u)); asm volatile("" : "+v"(lanep)); \
    const int tidp = wavep * 64 + lanep;     \
    const int gwp = vcup * NWAVES + wavep, gtp = vcup * 512 + tidp; (void)lanep; (void)wavep; (void)gwp; (void)gtp;
    if (IN(0)) { REPS(12) { const Args& a = fresh_args(); PH_IDS p0_prologue(a, lds, gwp, NGW, gtp, NGT, wavep, lanep); REP_BAR(12); } SEAM(0); }

#define WSP(T, off) ((T*)(a.ws + (off)))
#define WLP(off) ((const bf16*)(a.ws + WS_W + (size_t)l * WL_SIZE + (off)))
    for (int l = 0; l < DEPTH; ++l) {
        const int P = 1 + l * PH_PER_LAYER;
        if (IN(P + 0)) { REPS(0) {
            const Args& a = fresh_args(); PH_IDS
            bf16* XB = WSP(bf16, WS_XB); bf16* PROJ = WSP(bf16, WS_PROJ); const bf16* WIN = WLP(WL_WIN);
            { pg8::Gemm g{XB, WIN, MP, NPROJ, DM, DM, DM, 1 << 30, 0}; pg8::StaticOrder S; S.init(MP, NPROJ, G, bx);
              pg8::EpiBf16<0> E{PROJ, LDPJ, nullptr, 0, 0, 1.f};
              pg8::gemm_phase<pg8::EpiBf16<0>, pg8::StaticOrder, true, true>(lds, g, S, E, tidp); }
            __syncthreads();
            const FProj f{PROJ, WSP(float, WS_DT)};
            for (int r5_ = 0; r5_ < (((REP_MASK >> 19) & 1) ? 2 : 1); ++r5_)
            for (int u = vcup; u < 257 + 64; u += G) {
                if (u < 257) skinny_unit<4>(lds, XB + (size_t)MP * DM, DM, WIN + (size_t)u * 64 * DM, DM, DM, MP, 64 * u, f, wavep, lanep);
                else skinny_unit<4>(lds, XB + (size_t)(u - 257) * 128 * DM, DM, WIN + (size_t)NPROJ * DM, DM, DM, (u - 257) * 128, NPROJ, f, wavep, lanep);
            }
            REP_BAR(0); }
            SEAM(P + 0);
        }
        if (IN(P + 1)) { REPS(1) { const Args& a = fresh_args(); PH_IDS phase_a2(a, l, vcup, G, tidp, lanep, gwp, NGW, gtp, NGT); REP_BAR(1); } SEAM(P + 1); }
        if (IN(P + 2)) { REPS(2) {
            const Args& a = fresh_args(); PH_IDS
            if (G * 4 * NWAVES == NDEC * NH && G == NB * NH) {
                for (int r2_ = 0; r2_ < (((REP_MASK >> 13) & 1) ? 2 : 1); ++r2_) ssd_prompt_unit<false>(a, lds, l, vcup / NH, vcup % NH, tidp, wavep, lanep, 0, 0);
                for (int r2_ = 0; r2_ < (((REP_MASK >> 14) & 1) ? 2 : 1); ++r2_) ssd_decode_stream<4>(a, l, gwp, NGW, lanep);
            } else {
                for (int u = vcup; u < NB * NH; u += G) ssd_prompt_unit<false>(a, lds, l, u / NH, u % NH, tidp, wavep, lanep, 0, 0);
                for (int q = gwp; q < NDEC * NH; q += NGW) ssd_decode_pair(a, l, q / NH, q % NH, lanep);
            }
            REP_BAR(2); }
            SEAM(P + 2);
        }
        if (IN(P + 3)) { REPS(3) { const Args& a = fresh_args(); PH_IDS if (G != 256) phase_b2(a, l, gtp, NGT, 0); REP_BAR(3); } if (G != 256) SEAM(P + 3); }
        if (IN(P + 4)) { REPS(4) {
            const Args& a = fresh_args(); PH_IDS
            const bf16* POOLED = WSP(bf16, WS_POOLED); const bf16* WPOOL = WLP(WL_WPOOL);
            const FYb f{a.in[16] + (size_t)l * DP, WSP(bf16, WS_YB)};
            { pg8::Gemm g{POOLED, WPOOL, MP, DM, 512, DP, 512, 2, 512}; pg8::StaticOrder S; S.init(MP, DM, G, bx);
              Epi4<FYb> E{f}; pg8::gemm_phase<Epi4<FYb>, pg8::StaticOrder, true, true>(lds, g, S, E, tidp); }
            __syncthreads();
            if (G == 256) phase_b2(a, l, gtp, NGT, MP);
            for (int u = vcup; u < 128; u += G) skinny_unit<1>(lds, POOLED + (size_t)MP * DP + (u / 32) * 512, DP, WPOOL + (size_t)u * 16 * 512, 512, 512, MP, 16 * u, f, wavep, lanep);
            REP_BAR(4); }
            SEAM(P + 4);
        }
        if (IN(P + 5)) { REPS(5) {
            const Args& a = fresh_args(); PH_IDS
            const bf16* YN = WSP(bf16, WS_YN); const bf16* WBR = WLP(WL_WBR);
            const FMix f{WSP(bf16, WS_PROJ), a.in[7] + (size_t)l * 2 * DM, WSP(bf16, WS_YB), WSP(bf16, WS_MIX)};
            if (G == 256) {
                pg8::Gemm g{WSP(bf16, WS_V), WBR, MP, DM, DI, DI, DI, 1 << 30, 0}; pg8::StaticOrder S; S.init(MP, DM, G, bx);
                pg8::Unit u0; S.next(0, u0);
                if (tidp < 256) {
                    const float* sq = WSP(float, WS_SSQ) + (size_t)(u0.pm * 256 + tidp) * 64; float rs[8];
#pragma unroll
                    for (int gq = 0; gq < 8; ++gq) { const f32x4 q0 = *(const f32x4*)(sq + gq * 8), q1 = *(const f32x4*)(sq + gq * 8 + 4);
                        rs[gq] = rsqrtf(((q0[0] + q0[1]) + (q0[2] + q0[3]) + (q1[0] + q1[1]) + (q1[2] + q1[3])) * (1.f / 512.f) + RMS_EPS); }
                    LAS float* RT = (LAS float*)(lds + RT_OFF) + tidp * 8;
#pragma unroll
                    for (int gq = 0; gq < 8; ++gq) RT[gq] = gq < 7 ? rs[gq] / rs[gq + 1] : rs[7];
                }
                __syncthreads();
                Epi4K<FMix> E{f}; pg8::gemm_phase<Epi4K<FMix>, pg8::StaticOrder, true, true>(lds, g, S, E, tidp);
            } else { pg8::Gemm g{YN, WBR, MP, DM, DI, DI, DI, 1 << 30, 0}; pg8::StaticOrder S; S.init(MP, DM, G, bx);
              Epi4<FMix> E{f}; pg8::gemm_phase<Epi4<FMix>, pg8::StaticOrder, true, true>(lds, g, S, E, tidp); }
            __syncthreads();
            for (int r5_ = 0; r5_ < (((REP_MASK >> 17) & 1) ? 2 : 1); ++r5_)
            for (int u = vcup; u < 128; u += G) skinny_unit<1>(lds, YN + (size_t)MP * DI, DI, WBR + (size_t)u * 16 * DI, DI, DI, MP, 16 * u, f, wavep, lanep);
            REP_BAR(5); }
            SEAM(P + 5);
        }
        if (IN(P + 6)) { REPS(6) {
            const Args& a = fresh_args(); PH_IDS
            const bf16* MIX = WSP(bf16, WS_MIX); const bf16* WOUT = WLP(WL_WOUT);
            RowSrc xsrc; if (l == 0) { xsrc.p = a.in[0]; xsrc.s = a.in[1]; } else { xsrc.p = WSP(float, WS_XF); xsrc.s = WSP(float, WS_XF) + (size_t)MP * DM; }
            const FRes f{xsrc, WSP(float, WS_U)};
            { pg8::Gemm g{MIX, WOUT, MP, DM, DM, DM, DM, 1 << 30, 0}; pg8::StaticOrder S; S.init(MP, DM, G, bx);
              Epi4<FRes> E{f}; pg8::gemm_phase<Epi4<FRes>, pg8::StaticOrder, true, true>(lds, g, S, E, tidp); }
            __syncthreads();
            for (int u = vcup; u < 128; u += G) skinny_unit<1>(lds, MIX + (size_t)MP * DM, DM, WOUT + (size_t)u * 16 * DM, DM, DM, MP, 16 * u, f, wavep, lanep);
            REP_BAR(6); }
            SEAM(P + 6);
        }
        if (IN(P + 7)) { REPS(7) { const Args& a = fresh_args(); PH_IDS phase_ln(WSP(float, WS_U), a.in[18] + (size_t)l * DM, a.in[19] + (size_t)l * DM, WSP(float, WS_X1F), WSP(bf16, WS_X1B), gwp, NGW, lanep); REP_BAR(7); } SEAM(P + 7); }
        if (IN(P + 8)) { REPS(8) {
            const Args& a = fresh_args(); PH_IDS
            const bf16* X1B = WSP(bf16, WS_X1B); const bf16* WUP = WLP(WL_WUP); bf16* HPRE = WSP(bf16, WS_HPRE);
            { pg8::Gemm g{X1B, WUP, MP, 2 * DFF, DM, DM, DM, 1 << 30, 0}; pg8::StaticOrder S; S.init(MP, 2 * DFF, G, bx);
              pg8::EpiBf16<0> E{HPRE, 2 * DFF, nullptr, 0, 0, 1.f};
              pg8::gemm_phase<pg8::EpiBf16<0>, pg8::StaticOrder, true, true>(lds, g, S, E, tidp); }
            __syncthreads();
            const FBf f{HPRE, 2 * DFF};
            if (G == 256) { const int j = (bx + 160) & 255; for (int u = j; j < 160 && u < 172; u += 160) skinny_unit<4>(lds, X1B + (size_t)MP * DM, DM, WUP + (size_t)u * 64 * DM, DM, DM, MP, 64 * u, f, wavep, lanep); }
            else for (int u = vcup; u < 172; u += G) skinny_unit<4>(lds, X1B + (size_t)MP * DM, DM, WUP + (size_t)u * 64 * DM, DM, DM, MP, 64 * u, f, wavep, lanep);
            REP_BAR(8); }
            SEAM(P + 8);
        }
        if (IN(P + 9)) { REPS(9) { const Args& a = fresh_args(); PH_IDS phase_e2(a, l, vcup, G, tidp); REP_BAR(9); } SEAM(P + 9); }
        if (IN(P + 10)) { REPS(10) {
            const Args& a = fresh_args(); PH_IDS
            const bf16* HACT = WSP(bf16, WS_HACT); const bf16* WDOWN = WLP(WL_WDOWN);
            RowSrc x1; x1.p = WSP(float, WS_X1F); x1.s = WSP(float, WS_X1F) + (size_t)MP * DM;
            const FRes f{x1, WSP(float, WS_U)};
            { pg8::Gemm g{HACT, WDOWN, MP, DM, DFF, DFF, DFF, 1 << 30, 0}; pg8::StaticOrder S; S.init(MP, DM, G, bx);
              Epi4<FRes> E{f}; pg8::gemm_phase<Epi4<FRes>, pg8::StaticOrder, true, true>(lds, g, S, E, tidp); }
            __syncthreads();
            for (int r5_ = 0; r5_ < (((REP_MASK >> 18) & 1) ? 2 : 1); ++r5_)
            for (int u = vcup; u < 128; u += G) skinny_unit<1>(lds, HACT + (size_t)MP * DFF, DFF, WDOWN + (size_t)u * 16 * DFF, DFF, DFF, MP, 16 * u, f, wavep, lanep);
            REP_BAR(10); }
            SEAM(P + 10);
        }
        if (IN(P + 11)) { REPS(11) {
            const Args& a = fresh_args(); PH_IDS
            if (l == DEPTH - 1) phase_ln(WSP(float, WS_U), a.in[24] + (size_t)l * DM, a.in[25] + (size_t)l * DM, a.out + O_YP, nullptr, gwp, NGW, lanep);
            else phase_ln(WSP(float, WS_U), a.in[24] + (size_t)l * DM, a.in[25] + (size_t)l * DM, WSP(float, WS_XF), WSP(bf16, WS_XB), gwp, NGW, lanep);
            REP_BAR(11); }
            if (l != DEPTH - 1) SEAM(P + 11);
        }
    }
#undef WSP
#undef WLP
    if (TSEC != 0) { __syncthreads(); if (blockIdx.x == 0 && tid == 0) { const unsigned long long t0_ = __builtin_amdgcn_s_memrealtime(), d_ = 8ull * MISC[16]; while (__builtin_amdgcn_s_memrealtime() - t0_ < d_) __builtin_amdgcn_s_sleep(8); } }
#undef IN
#undef SEAM
}

extern "C" void kernel_launch(void* const* d_in, const int* in_sizes, int n_in, void* d_out, int out_size, void* d_ws, size_t ws_size, hipStream_t stream) {
    static int grid = 0;
    if (grid == 0) {
        if (n_in != 26 || (size_t)out_size != O_END || ws_size < WS_END) { fprintf(stderr, "kernel_launch: unexpected n_in %d / out_size %d / ws %zu (want 26 / %zu / >= %zu)\n", n_in, out_size, ws_size, (size_t)O_END, (size_t)WS_END); grid = -1; return; }
        int dev = 0, cus = 0, per_cu = 0;
        if (hipGetDevice(&dev) != hipSuccess || hipDeviceGetAttribute(&cus, hipDeviceAttributeMultiprocessorCount, dev) != hipSuccess) { grid = -1; return; }
        if (hipFuncSetAttribute((const void*)mega_fwd, hipFuncAttributeMaxDynamicSharedMemorySize, LDS_BYTES) != hipSuccess) { fprintf(stderr, "kernel_launch: hipFuncSetAttribute failed\n"); grid = -1; return; }
        if (hipOccupancyMaxActiveBlocksPerMultiprocessor(&per_cu, (const void*)mega_fwd, NWAVES * 64, LDS_BYTES) != hipSuccess || per_cu < 1) { fprintf(stderr, "kernel_launch: occupancy query says %d blocks per CU\n", per_cu); (void)hipGetLastError(); grid = -1; return; }
        grid = cus;
    }
    if (grid < 0) return;
    if (hipMemsetAsync((char*)d_ws + WS_CTL, 0, CTL_ZERO_BYTES, stream) != hipSuccess) return;
    Args a{};
    for (int i = 0; i < 26; ++i) a.in[i] = (const float*)d_in[i];
    a.out = (float*)d_out; a.ws = (unsigned char*)d_ws;
#if MK_PER_PHASE
    for (int p = 0; p < N_PHASES; ++p) { a.ph_lo = p; a.ph_hi = p + 1; hipLaunchKernelGGL(mega_fwd, dim3(grid), dim3(NWAVES * 64), LDS_BYTES, stream, a); }
#else
    a.ph_lo = 0; a.ph_hi = N_PHASES;
    hipLaunchKernelGGL(mega_fwd, dim3(grid), dim3(NWAVES * 64), LDS_BYTES, stream, a);
#endif
}
```
